# Optimizing an MI355X kernel written in HIP

```python
import math
import jax
import jax.numpy as jnp
from jax import lax
import numpy as np

D_MODEL = 1024
BATCH = 8
SEQ = 4096
DEPTH = 2

HEAD_DIM = 64
SB_HEADS = 8
SWA_HEADS = 8
SWA_KV_HEADS = 2
SWA_GROUP = SWA_HEADS // SWA_KV_HEADS
WINDOW = 128
BLOCK = 128
D_FF = 4 * D_MODEL
ROPE_THETA = 10000.0
EPS = 1e-6
NEG = -1e30

SB_W = SB_HEADS * HEAD_DIM
SWA_Q_W = SWA_HEADS * HEAD_DIM
SWA_KV_W = SWA_KV_HEADS * HEAD_DIM
MIX_W = SB_W + SWA_Q_W
IN_W = 3 * SB_W + SWA_Q_W + 2 * SWA_KV_W

kernel_name = "hybrid_stickbreak_swa_sink_block"


def rmsnorm(x, g):
    xf = x.astype(jnp.float32)
    y = xf * lax.rsqrt(jnp.mean(xf * xf, axis=-1, keepdims=True) + EPS)
    return (y * g.astype(jnp.float32)).astype(x.dtype)


def rope(x, positions):
    half = HEAD_DIM // 2
    inv_freq = 1.0 / (ROPE_THETA ** (jnp.arange(half, dtype=jnp.float32) * (2.0 / HEAD_DIM)))
    ang = positions.astype(jnp.float32)[:, None] * inv_freq[None, :]
    cos = jnp.cos(ang)[None, :, None, :]
    sin = jnp.sin(ang)[None, :, None, :]
    xf = x.astype(jnp.float32)
    x1, x2 = xf[..., :half], xf[..., half:]
    out = jnp.concatenate([x1 * cos - x2 * sin, x2 * cos + x1 * sin], axis=-1)
    return out.astype(x.dtype)


def stick_breaking_attention(q, k, v):
    B, S, H, D = q.shape
    scale = 1.0 / math.sqrt(D)
    qh = jnp.transpose(q, (0, 2, 1, 3))
    kh = jnp.transpose(k, (0, 2, 1, 3))
    vh = jnp.transpose(v, (0, 2, 1, 3)).astype(jnp.float32)
    outs = []
    for i in range(S // BLOCK):
        end = (i + 1) * BLOCK
        qb = qh[:, :, i * BLOCK:end]
        z = jnp.einsum('bhqd,bhkd->bhqk', qb, kh[:, :, :end]).astype(jnp.float32) * scale
        t_pos = i * BLOCK + jnp.arange(BLOCK)[:, None]
        s_pos = jnp.arange(end)[None, :]
        strict = s_pos < t_pos
        log_beta = jax.nn.log_sigmoid(z)
        log_1m = jnp.where(strict, -jax.nn.softplus(z), 0.0)
        suffix = lax.cumsum(log_1m, axis=3, reverse=True) - log_1m
        a = jnp.where(strict, jnp.exp(log_beta + suffix), 0.0)
        outs.append(jnp.einsum('bhqk,bhkd->bhqd', a, vh[:, :, :end]))
    o = jnp.concatenate(outs, axis=2)
    return jnp.transpose(o, (0, 2, 1, 3)).astype(v.dtype)


def sliding_window_sink_attention(q, k, v, sinks):
    B, S, Hq, D = q.shape
    nblk = S // BLOCK
    scale = 1.0 / math.sqrt(D)
    qb = q.reshape(B, nblk, BLOCK, SWA_KV_HEADS, SWA_GROUP, D)
    pad = ((0, 0), (BLOCK, 0), (0, 0), (0, 0))
    kp = jnp.pad(k, pad).reshape(B, nblk + 1, BLOCK, SWA_KV_HEADS, D)
    vp = jnp.pad(v, pad).reshape(B, nblk + 1, BLOCK, SWA_KV_HEADS, D)
    kb = jnp.concatenate([kp[:, :-1], kp[:, 1:]], axis=2)
    vb = jnp.concatenate([vp[:, :-1], vp[:, 1:]], axis=2)
    s = jnp.einsum('bnqkgd,bnskd->bnkgqs', qb, kb).astype(jnp.float32) * scale
    q_rel = BLOCK + jnp.arange(BLOCK)[:, None]
    k_rel = jnp.arange(2 * BLOCK)[None, :]
    diff = q_rel - k_rel
    k_abs = (jnp.arange(nblk)[:, None, None] - 1) * BLOCK + k_rel[None]
    mask = (diff >= 0)[None] & (diff < WINDOW)[None] & (k_abs >= 0)
    mask = mask[None, :, None, None]
    s = jnp.where(mask, s, NEG)
    sink = sinks.astype(jnp.float32).reshape(1, 1, SWA_KV_HEADS, SWA_GROUP, 1, 1)
    m = jnp.maximum(jnp.max(s, axis=-1, keepdims=True), sink)
    p = jnp.where(mask, jnp.exp(s - m), 0.0)
    probs = p / (jnp.sum(p, axis=-1, keepdims=True) + jnp.exp(sink - m))
    o = jnp.einsum('bnkgqs,bnskd->bnqkgd', probs, vb.astype(jnp.float32))
    return o.reshape(B, S, Hq, D).astype(v.dtype)


def setup_inputs(seed: int = 0) -> dict:
    key = jax.random.key(seed)
    ks = jax.random.split(key, 12)
    f32 = jnp.float32
    x = jax.random.normal(ks[0], (BATCH, SEQ, D_MODEL), f32)
    positions = jnp.arange(SEQ, dtype=jnp.int32)
    attn_norm = 1.0 + 0.02 * jax.random.normal(ks[1], (DEPTH, D_MODEL), f32)
    w_in = jax.random.normal(ks[2], (DEPTH, D_MODEL, IN_W), f32) * D_MODEL ** -0.5
    sb_norm = 1.0 + 0.02 * jax.random.normal(ks[3], (DEPTH, SB_W), f32)
    swa_norm = 1.0 + 0.02 * jax.random.normal(ks[4], (DEPTH, SWA_Q_W), f32)
    sinks = 0.5 * jax.random.normal(ks[5], (DEPTH, SWA_HEADS), f32)
    w_out = jax.random.normal(ks[6], (DEPTH, MIX_W, D_MODEL), f32) * MIX_W ** -0.5
    mlp_norm = 1.0 + 0.02 * jax.random.normal(ks[7], (DEPTH, D_MODEL), f32)
    w_up = jax.random.normal(ks[8], (DEPTH, D_MODEL, D_FF), f32) * D_MODEL ** -0.5
    w_down = jax.random.normal(ks[9], (DEPTH, D_FF, D_MODEL), f32) * D_FF ** -0.5
    final_norm = 1.0 + 0.02 * jax.random.normal(ks[10], (D_MODEL,), f32)
    return {"x": x, "positions": positions, "attn_norm": attn_norm, "w_in": w_in,
            "sb_norm": sb_norm, "swa_norm": swa_norm, "sinks": sinks, "w_out": w_out,
            "mlp_norm": mlp_norm, "w_up": w_up, "w_down": w_down, "final_norm": final_norm}


def reference(x, positions, attn_norm, w_in, sb_norm, swa_norm, sinks, w_out,
              mlp_norm, w_up, w_down, final_norm):
    B, S, _ = x.shape
    splits = np.cumsum([SB_W, SB_W, SB_W, SWA_Q_W, SWA_KV_W]).tolist()
    for l in range(DEPTH):
        h = rmsnorm(x, attn_norm[l])
        proj = jnp.einsum('bsd,de->bse', h, w_in[l])
        sb_q, sb_k, sb_v, sw_q, sw_k, sw_v = jnp.split(proj, splits, axis=-1)
        sb_o = stick_breaking_attention(sb_q.reshape(B, S, SB_HEADS, HEAD_DIM),
                                        sb_k.reshape(B, S, SB_HEADS, HEAD_DIM),
                                        sb_v.reshape(B, S, SB_HEADS, HEAD_DIM))
        sw_q = rope(sw_q.reshape(B, S, SWA_HEADS, HEAD_DIM), positions)
        sw_k = rope(sw_k.reshape(B, S, SWA_KV_HEADS, HEAD_DIM), positions)
        sw_o = sliding_window_sink_attention(sw_q, sw_k,
                                             sw_v.reshape(B, S, SWA_KV_HEADS, HEAD_DIM),
                                             sinks[l])
        mix = jnp.concatenate([rmsnorm(sb_o.reshape(B, S, SB_W), sb_norm[l]),
                               rmsnorm(sw_o.reshape(B, S, SWA_Q_W), swa_norm[l])], axis=-1)
        x = x + jnp.einsum('bse,ed->bsd', mix, w_out[l]).astype(x.dtype)
        h = rmsnorm(x, mlp_norm[l])
        u = jnp.square(jax.nn.relu(jnp.einsum('bsd,df->bsf', h, w_up[l])))
        x = x + jnp.einsum('bsf,fd->bsd', u, w_down[l]).astype(x.dtype)
    return rmsnorm(x, final_norm)
```

```cpp
#include <hip/hip_runtime.h>
#include <hip/hip_cooperative_groups.h>
#include <cstdio>
#include <cstdint>
#include <cmath>
namespace pg8 {
#define PG8_LAS __attribute__((address_space(3)))
typedef unsigned short bf16_t;
typedef short bf16x8 __attribute__((ext_vector_type(8)));
typedef float f32x4 __attribute__((ext_vector_type(4)));
typedef unsigned u32x4 __attribute__((ext_vector_type(4)));
constexpr int BM = 256, BK = 64, HALF = 128, HTB = HALF * BK * 2  , STAGE_BYTES = 8 * HTB, NXCD = 8, WGM = 8;

__host__ __device__ __forceinline__ int lds_byte(int r, int c) { const int st = (r >> 4) * 2 + (c >> 5), rr = r & 15, cc = c & 31, ob = rr * 64 + cc * 2; return st * 1024 + (ob ^ (((ob >> 9) & 1) << 5)); }
__host__ __device__ __forceinline__ void stage_rc(int b, int& R, int& C) { const int st = b / 1024, sb = b % 1024, swz = sb ^ (((sb >> 9) & 1) << 5); R = (st >> 1) * 16 + swz / 64; C = (st & 1) * 32 + (swz % 64) / 2; }
__host__ __device__ __forceinline__ int perm32(int rho) { const int n = rho >> 4, i = rho & 15; return 8 * (i >> 2) + 4 * n + (i & 3); }

struct Unit { int pm, pn; };
struct Gemm { const bf16_t* A; const bf16_t* Bt; int M, N, K; };

struct StaticOrder {
    int nM, nN, nwg, G, c;
    __host__ __device__ void init(int M, int N, int G_, int c_) { nM = M / BM; nN = N / BM; nwg = nM * nN; G = G_; c = c_; }
    __host__ __device__ bool next(int i, Unit& u) const {
        const long L = (long)i * G + c; if (L >= nwg) return false;
        int wgid = (int)L; { const int q = nwg / NXCD, r = nwg % NXCD, xcd = wgid % NXCD, off = wgid / NXCD; wgid = (xcd < r ? xcd * (q + 1) : r * (q + 1) + (xcd - r) * q) + off; }
        const int nig = WGM * nN, gid = wgid / nig, fm = gid * WGM, gsz = (nM - fm) < WGM ? (nM - fm) : WGM;
        u.pm = fm + ((wgid % nig) % gsz); u.pn = (wgid % nig) / gsz; return true;
    }
    __device__ __forceinline__ void a_ready(const Unit&) const {}
    __device__ __forceinline__ void done(const Unit&) const {}
};

__device__ __forceinline__ unsigned cvt_pk_bf16(float lo, float hi) { unsigned r; asm volatile("v_cvt_pk_bf16_f32 %0, %1, %2" : "=v"(r) : "v"(lo), "v"(hi)); return r; }
typedef float f32x2 __attribute__((ext_vector_type(2)));

typedef unsigned u32x2 __attribute__((ext_vector_type(2)));
constexpr float RMS_EPS = 1e-6f;
constexpr float QSCALE = 0.125f * 1.4426950408889634f;
constexpr int NPA = 1792;
struct EpiProj {
    static constexpr bool PERM = true, AFTER_DRAIN = false;
    bf16_t* O; const float* ssq; const float* rope;
    __device__ __forceinline__ void operator()(const f32x4 (&acc)[2][2][4][2], const Unit& u, int wr, int wc, int fr, int fq) const {
        const int row0 = u.pm * BM + wr * 64 + fr, col0 = u.pn * BM + wc * 32 + 8 * fq;
        const int pn = u.pn;
        const bool rope0 = (pn >= 4), rope1 = (pn == 4 || pn == 5);
        const float sc = (pn <= 1 || pn == 4 || pn == 5) ? QSCALE : 1.0f;
        const int i0 = ((wc * 32 + 8 * fq) & 63) >> 1;
#pragma unroll
        for (int ai = 0; ai < 2; ++ai)
#pragma unroll
            for (int m = 0; m < 4; ++m) {
                const int row = row0 + ai * HALF + m * 16;
                const float rs = __builtin_amdgcn_rsqf(ssq[row] * (1.0f / 1024.0f) + RMS_EPS) * sc;
                f32x4 cs0 = (f32x4){1.f, 0.f, 1.f, 0.f}, cs1 = cs0;
                if (rope0) { const f32x4* rp = (const f32x4*)(rope + ((size_t)(row & 4095) * 32 + i0) * 2); cs0 = rp[0]; cs1 = rp[1]; }
                bf16_t* rowp = O + (size_t)row * NPA + col0;
#pragma unroll
                for (int bj = 0; bj < 2; ++bj) {
                    f32x4 v0 = acc[ai][bj][m][0] * rs, v1 = acc[ai][bj][m][1] * rs;
                    if (bj == 0 ? rope0 : rope1) {
                        v0 = (f32x4){v0[0] * cs0[0] - v0[1] * cs0[1], v0[1] * cs0[0] + v0[0] * cs0[1], v0[2] * cs0[2] - v0[3] * cs0[3], v0[3] * cs0[2] + v0[2] * cs0[3]};
                        v1 = (f32x4){v1[0] * cs1[0] - v1[1] * cs1[1], v1[1] * cs1[0] + v1[0] * cs1[1], v1[2] * cs1[2] - v1[3] * cs1[3], v1[3] * cs1[2] + v1[2] * cs1[3]};
                    }
                    u32x4 w; w.x = cvt_pk_bf16(v0[0], v0[1]); w.y = cvt_pk_bf16(v0[2], v0[3]); w.z = cvt_pk_bf16(v1[0], v1[1]); w.w = cvt_pk_bf16(v1[2], v1[3]);
                    *(u32x4*)(rowp + bj * HALF) = w;
                }
            }
    }
};
struct EpiVT {
    static constexpr bool PERM = true, AFTER_DRAIN = false;
    bf16_t* O; const float* ssq; int ldc;
    __device__ __forceinline__ void operator()(const f32x4 (&acc)[2][2][4][2], const Unit& u, int wr, int wc, int fr, int fq) const {
        const int row0 = u.pm * BM + wr * 64 + fr, col0 = u.pn * BM + wc * 32 + 8 * fq;
        f32x4 rs[2][2];
#pragma unroll
        for (int bj = 0; bj < 2; ++bj)
#pragma unroll
            for (int n = 0; n < 2; ++n) { const f32x4 s = *(const f32x4*)(ssq + col0 + bj * HALF + 4 * n);
                rs[bj][n] = (f32x4){__builtin_amdgcn_rsqf(s[0] * (1.0f / 1024.0f) + RMS_EPS), __builtin_amdgcn_rsqf(s[1] * (1.0f / 1024.0f) + RMS_EPS),
                                    __builtin_amdgcn_rsqf(s[2] * (1.0f / 1024.0f) + RMS_EPS), __builtin_amdgcn_rsqf(s[3] * (1.0f / 1024.0f) + RMS_EPS)}; }
#pragma unroll
        for (int ai = 0; ai < 2; ++ai)
#pragma unroll
            for (int m = 0; m < 4; ++m) { bf16_t* rowp = O + (size_t)(row0 + ai * HALF + m * 16) * ldc + col0;
#pragma unroll
                for (int bj = 0; bj < 2; ++bj) { const f32x4 v0 = acc[ai][bj][m][0] * rs[bj][0], v1 = acc[ai][bj][m][1] * rs[bj][1];
                    u32x4 w; w.x = cvt_pk_bf16(v0[0], v0[1]); w.y = cvt_pk_bf16(v0[2], v0[3]); w.z = cvt_pk_bf16(v1[0], v1[1]); w.w = cvt_pk_bf16(v1[2], v1[3]);
                    *(u32x4*)(rowp + bj * HALF) = w; } }
    }
};
struct EpiRes {
    static constexpr bool PERM = true, AFTER_DRAIN = false;
    const float* res; float* out; bf16_t* xb; float* ssq_out;
    __device__ __forceinline__ void operator()(const f32x4 (&acc)[2][2][4][2], const Unit& u, int wr, int wc, int fr, int fq) const {
        const int row0 = u.pm * BM + wr * 64 + fr, col0 = u.pn * BM + wc * 32 + 8 * fq;
#pragma unroll
        for (int ai = 0; ai < 2; ++ai)
#pragma unroll
            for (int m = 0; m < 4; ++m) { const int row = row0 + ai * HALF + m * 16; const size_t off = (size_t)row * 1024 + col0; float ss = 0.f;
#pragma unroll
                for (int bj = 0; bj < 2; ++bj) {
                    const f32x4 v0 = acc[ai][bj][m][0] + *(const f32x4*)(res + off + bj * HALF), v1 = acc[ai][bj][m][1] + *(const f32x4*)(res + off + bj * HALF + 4);
                    *(f32x4*)(out + off + bj * HALF) = v0; *(f32x4*)(out + off + bj * HALF + 4) = v1;
                    ss += (v0[0] * v0[0] + v0[1] * v0[1]) + (v0[2] * v0[2] + v0[3] * v0[3]) + (v1[0] * v1[0] + v1[1] * v1[1]) + (v1[2] * v1[2] + v1[3] * v1[3]);
                    u32x4 w; w.x = cvt_pk_bf16(v0[0], v0[1]); w.y = cvt_pk_bf16(v0[2], v0[3]); w.z = cvt_pk_bf16(v1[0], v1[1]); w.w = cvt_pk_bf16(v1[2], v1[3]);
                    *(u32x4*)(xb + off + bj * HALF) = w; }
                ss += __shfl_xor(ss, 16); ss += __shfl_xor(ss, 32);
                if (fq == 0) atomicAdd(ssq_out + row, ss); }
    }
};
struct EpiUp {
    static constexpr bool PERM = true, AFTER_DRAIN = false;
    bf16_t* O; const float* ssq; int ldc;
    __device__ __forceinline__ void operator()(const f32x4 (&acc)[2][2][4][2], const Unit& u, int wr, int wc, int fr, int fq) const {
        const int row0 = u.pm * BM + wr * 64 + fr, col0 = u.pn * BM + wc * 32 + 8 * fq;
#pragma unroll
        for (int ai = 0; ai < 2; ++ai)
#pragma unroll
            for (int m = 0; m < 4; ++m) { const int row = row0 + ai * HALF + m * 16; const float rs = __builtin_amdgcn_rsqf(ssq[row] * (1.0f / 1024.0f) + RMS_EPS);
                bf16_t* rowp = O + (size_t)row * ldc + col0;
#pragma unroll
                for (int bj = 0; bj < 2; ++bj) { f32x4 v0 = acc[ai][bj][m][0] * rs, v1 = acc[ai][bj][m][1] * rs;
                    v0 = __builtin_elementwise_max(v0, (f32x4){0.f, 0.f, 0.f, 0.f}); v1 = __builtin_elementwise_max(v1, (f32x4){0.f, 0.f, 0.f, 0.f}); v0 = v0 * v0; v1 = v1 * v1;
                    u32x4 w; w.x = cvt_pk_bf16(v0[0], v0[1]); w.y = cvt_pk_bf16(v0[2], v0[3]); w.z = cvt_pk_bf16(v1[0], v1[1]); w.w = cvt_pk_bf16(v1[2], v1[3]);
                    *(u32x4*)(rowp + bj * HALF) = w; } }
    }
};

template <class Epi, class Sched, bool ALIGN_EPI = false, bool SP2 = false>
__device__ __forceinline__ void gemm_phase(PG8_LAS unsigned char* lds, const Gemm g, const Sched& S, const Epi& E) {
    int tid_l = threadIdx.x; asm volatile("" : "+v"(tid_l));
    const int tid = tid_l, wid = __builtin_amdgcn_readfirstlane(tid >> 6), lane = tid & 63, wr = wid >> 2, wc = wid & 3, fr = lane & 15, fq = lane >> 4;
    const int K = g.K, nt = K / BK;
    unsigned voffA[2], voffB[2];
#pragma unroll
    for (int i = 0; i < 2; ++i) { int R, C; stage_rc(tid * 16 + i * 8192, R, C); const int Rb = Epi::PERM ? ((R & ~31) + perm32(R & 31)) : R;
        voffA[i] = (unsigned)(R * K + C) * 2u; voffB[i] = (unsigned)(Rb * K + C) * 2u; }
    const size_t kstep = (size_t)(BK * 2);
    const size_t hstep = (size_t)HALF * K * 2;
    const size_t tstep = 2 * hstep;
    const unsigned ldsw = (unsigned)wid * 1024u;
    const int aoff = lds_byte(wr * 64 + fr, fq * 8), boff = lds_byte(wc * 32 + fr, fq * 8);
#define PG8_SA(b, h) (((b) * 2 + (h)) * HTB)
#define PG8_SB(b, h) ((4 + (b) * 2 + (h)) * HTB)
#define PG8_STAGE(bufoff, gbase, voff) do { _Pragma("unroll") for (int _i = 0; _i < 2; ++_i) \
        __builtin_amdgcn_global_load_lds((const unsigned*)((const char*)(gbase) + (voff)[_i]), (PG8_LAS unsigned*)(lds + (bufoff) + ldsw + _i * 8192), 16, 0, 0); } while (0)
#define PG8_LDA(dst, b, h) do { _Pragma("unroll") for (int m = 0; m < 4; ++m) _Pragma("unroll") for (int k = 0; k < 2; ++k) dst[m][k] = *(const PG8_LAS bf16x8*)(lds + PG8_SA(b, h) + aoff + m * 2048 + k * 1024); } while (0)
#define PG8_LDB(dst, b, h) do { _Pragma("unroll") for (int n = 0; n < 2; ++n) _Pragma("unroll") for (int k = 0; k < 2; ++k) dst[n][k] = *(const PG8_LAS bf16x8*)(lds + PG8_SB(b, h) + boff + n * 2048 + k * 1024); } while (0)
#define PG8_MMA(ai, bj, At, Bt) do { __builtin_amdgcn_s_setprio(1); _Pragma("unroll") for (int m = 0; m < 4; ++m) _Pragma("unroll") for (int n = 0; n < 2; ++n) _Pragma("unroll") for (int k = 0; k < 2; ++k) \
        acc[ai][bj][m][n] = __builtin_amdgcn_mfma_f32_16x16x32_bf16(Bt[n][k], At[m][k], acc[ai][bj][m][n], 0, 0, 0); __builtin_amdgcn_s_setprio(0); } while (0)
#define PG8_WAIT_V(n) asm volatile("s_waitcnt vmcnt(" #n ")" ::: "memory")
#define PG8_WAIT_L(n) asm volatile("s_waitcnt lgkmcnt(" #n ")" ::: "memory")
#define PG8_BAR __builtin_amdgcn_s_barrier()
#define PG8_SCHED __builtin_amdgcn_sched_barrier(0)
    Unit cur, nxt; int ui = 0;
    if (!S.next(0, cur)) return;
    f32x4 acc[2][2][4][2];
#pragma unroll
    for (int a = 0; a < 2; ++a)
#pragma unroll
        for (int b = 0; b < 2; ++b)
#pragma unroll
            for (int m = 0; m < 4; ++m)
#pragma unroll
                for (int n = 0; n < 2; ++n) acc[a][b][m][n] = (f32x4){0.f, 0.f, 0.f, 0.f};
    bf16x8 At[4][2], B0[2][2], B1[2][2];
    const char* cA = (const char*)g.A + (size_t)cur.pm * tstep; const char* cB = (const char*)g.Bt + (size_t)cur.pn * tstep;
    S.a_ready(cur);
    if constexpr (SP2) {
        PG8_STAGE(PG8_SB(0, 0), cB, voffB); PG8_STAGE(PG8_SB(0, 1), cB + hstep, voffB); PG8_STAGE(PG8_SA(0, 0), cA, voffA); PG8_STAGE(PG8_SA(0, 1), cA + hstep, voffA);
        if (wr == 1) PG8_BAR;
        PG8_WAIT_V(2); PG8_BAR;
        PG8_STAGE(PG8_SB(1, 0), cB + kstep, voffB); PG8_STAGE(PG8_SA(1, 0), cA + kstep, voffA); PG8_STAGE(PG8_SB(1, 1), cB + hstep + kstep, voffB);
        PG8_WAIT_V(6); PG8_BAR;
    } else {
        PG8_STAGE(PG8_SB(0, 0), cB, voffB); PG8_STAGE(PG8_SA(0, 0), cA, voffA); PG8_STAGE(PG8_SB(0, 1), cB + hstep, voffB); PG8_STAGE(PG8_SA(0, 1), cA + hstep, voffA);
        if (wr == 1) PG8_BAR;
        PG8_WAIT_V(4); PG8_BAR;
        PG8_STAGE(PG8_SB(1, 0), cB + kstep, voffB); PG8_STAGE(PG8_SA(1, 0), cA + kstep, voffA); PG8_STAGE(PG8_SB(1, 1), cB + hstep + kstep, voffB);
        PG8_WAIT_V(6); PG8_BAR;
    }
    for (;;) {
        const bool has_next = S.next(ui + 1, nxt);
        const char* nA = has_next ? (const char*)g.A + (size_t)nxt.pm * tstep : cA; const char* nB = has_next ? (const char*)g.Bt + (size_t)nxt.pn * tstep : cB;
        for (int t = 0; t < nt; t += 2) {
            const bool last = (t == nt - 2);
            const char* a1 = cA + (size_t)(t + 1) * kstep;
            const char* a2 = last ? nA : cA + (size_t)(t + 2) * kstep; const char* b2 = last ? nB : cB + (size_t)(t + 2) * kstep;
            const char* a3 = a2 + kstep; const char* b3 = b2 + kstep;
            if (last && has_next) S.a_ready(nxt);
            if constexpr (SP2) {
            PG8_LDB(B0, 0, 0); PG8_LDB(B1, 0, 1); PG8_SCHED; PG8_LDA(At, 0, 0); PG8_STAGE(PG8_SA(1, 1), a1 + hstep, voffA);
            PG8_WAIT_V(8); PG8_WAIT_L(0); PG8_BAR; PG8_MMA(0, 0, At, B0); PG8_MMA(0, 1, At, B1); PG8_BAR; PG8_SCHED;
            PG8_LDA(At, 0, 1); PG8_STAGE(PG8_SB(0, 0), b2, voffB); PG8_STAGE(PG8_SB(0, 1), b2 + hstep, voffB); PG8_STAGE(PG8_SA(0, 0), a2, voffA);
            PG8_WAIT_V(8); PG8_WAIT_L(0); PG8_BAR; PG8_MMA(1, 0, At, B0); PG8_MMA(1, 1, At, B1); PG8_BAR; PG8_SCHED;
            PG8_LDB(B0, 1, 0); PG8_LDB(B1, 1, 1); PG8_SCHED; PG8_LDA(At, 1, 0); PG8_STAGE(PG8_SA(0, 1), a2 + hstep, voffA);
            PG8_WAIT_V(8); PG8_WAIT_L(0); PG8_BAR; PG8_MMA(0, 0, At, B0); PG8_MMA(0, 1, At, B1); PG8_BAR; PG8_SCHED;
            PG8_LDA(At, 1, 1); PG8_STAGE(PG8_SB(1, 0), b3, voffB); PG8_STAGE(PG8_SB(1, 1), b3 + hstep, voffB); PG8_STAGE(PG8_SA(1, 0), a3, voffA);
            PG8_WAIT_V(8); PG8_WAIT_L(0); PG8_BAR; PG8_MMA(1, 0, At, B0); PG8_MMA(1, 1, At, B1); PG8_BAR; PG8_SCHED;
            } else {
            PG8_LDB(B0, 0, 0); PG8_SCHED; PG8_LDA(At, 0, 0); PG8_STAGE(PG8_SA(1, 1), a1 + hstep, voffA);
            PG8_WAIT_L(8); PG8_BAR; PG8_WAIT_L(0); PG8_MMA(0, 0, At, B0); PG8_BAR; PG8_SCHED;
            PG8_LDB(B1, 0, 1); PG8_STAGE(PG8_SB(0, 0), b2, voffB);
            PG8_BAR; PG8_WAIT_L(0); PG8_MMA(0, 1, At, B1); PG8_BAR;
            PG8_LDA(At, 0, 1); PG8_STAGE(PG8_SA(0, 0), a2, voffA);
            PG8_BAR; PG8_WAIT_L(0); PG8_MMA(1, 0, At, B0); PG8_BAR; PG8_SCHED;
            PG8_STAGE(PG8_SB(0, 1), b2 + hstep, voffB);
            PG8_WAIT_V(6); PG8_BAR; PG8_MMA(1, 1, At, B1); PG8_BAR;
            PG8_LDB(B0, 1, 0); PG8_SCHED; PG8_LDA(At, 1, 0); PG8_STAGE(PG8_SA(0, 1), a2 + hstep, voffA);
            PG8_WAIT_L(8); PG8_BAR; PG8_WAIT_L(0); PG8_MMA(0, 0, At, B0); PG8_BAR; PG8_SCHED;
            PG8_LDB(B1, 1, 1); PG8_STAGE(PG8_SB(1, 0), b3, voffB);
            PG8_BAR; PG8_WAIT_L(0); PG8_MMA(0, 1, At, B1); PG8_BAR;
            PG8_LDA(At, 1, 1); PG8_STAGE(PG8_SA(1, 0), a3, voffA);
            PG8_BAR; PG8_WAIT_L(0); PG8_MMA(1, 0, At, B0); PG8_BAR; PG8_SCHED;
            PG8_STAGE(PG8_SB(1, 1), b3 + hstep, voffB);
            PG8_WAIT_V(6); PG8_BAR; PG8_MMA(1, 1, At, B1); PG8_BAR;
            }
        }
        if constexpr (ALIGN_EPI) { if (wr == 0) PG8_BAR; }
        if constexpr (!Epi::AFTER_DRAIN) { E(acc, cur, wr, wc, fr, fq); S.done(cur); }
        if (!has_next) break;
#pragma unroll
        for (int a = 0; a < 2; ++a)
#pragma unroll
            for (int b = 0; b < 2; ++b)
#pragma unroll
                for (int m = 0; m < 4; ++m)
#pragma unroll
                    for (int n = 0; n < 2; ++n) acc[a][b][m][n] = (f32x4){0.f, 0.f, 0.f, 0.f};
        cur = nxt; cA = nA; cB = nB; ++ui;
        if constexpr (ALIGN_EPI) { if (wr == 1) PG8_BAR; }
    }
    PG8_WAIT_V(0);
    if constexpr (!ALIGN_EPI) { if (wr == 0) PG8_BAR; }
    PG8_BAR;
    if constexpr (Epi::AFTER_DRAIN) { E.fused(acc, cur, wr, wc, fr, fq, lds, wid, lane); S.done(cur); }
#undef PG8_SA
#undef PG8_SB
#undef PG8_STAGE
#undef PG8_LDA
#undef PG8_LDB
#undef PG8_MMA
#undef PG8_WAIT_V
#undef PG8_WAIT_L
#undef PG8_BAR
#undef PG8_SCHED
}
}

namespace cg = cooperative_groups;
#define LAS __attribute__((address_space(3)))
typedef unsigned short bf16;
typedef short bf16x8 __attribute__((ext_vector_type(8)));
typedef float f32x4 __attribute__((ext_vector_type(4)));
typedef float f32x16 __attribute__((ext_vector_type(16)));
typedef unsigned u32x4 __attribute__((ext_vector_type(4)));
typedef unsigned u32x2 __attribute__((ext_vector_type(2)));

constexpr int NWAVES = 8;
constexpr int BATCH = 8, SEQ = 4096, DM = 1024, MTOK = BATCH * SEQ, DFF = 4096, DEPTH = 2, INW = 2304;
constexpr int NPA = pg8::NPA;
constexpr float RMS_EPS = 1e-6f;
constexpr size_t MiB = 1u << 20;
constexpr size_t WS_SSQ = 1 * MiB;
constexpr size_t WS_MISC = 3 * MiB;
constexpr size_t WS_ROPE = 2 * MiB;
constexpr size_t WS_W = 4 * MiB;
constexpr size_t W_IN = 0, W_OUT = (size_t)INW * DM * 2, W_UP = W_OUT + (size_t)DM * DM * 2, W_DOWN = W_UP + (size_t)DFF * DM * 2, W_LAYER = W_DOWN + (size_t)DM * DFF * 2;
constexpr size_t WS_XB = 52 * MiB;
constexpr size_t WS_MIX = 116 * MiB;
constexpr size_t WS_H = 180 * MiB;
constexpr size_t WS_PA = 180 * MiB;
constexpr size_t WS_VT = 292 * MiB;
constexpr size_t WS_END = 436 * MiB;
static_assert(WS_W + DEPTH * W_LAYER <= WS_XB && WS_PA + (size_t)MTOK * NPA * 2 <= WS_VT && WS_VT + (size_t)512 * MTOK * 2 <= WS_END, "d_ws map");
constexpr int LDS_BYTES = 147456;

#define MFMA32(a, b, c) __builtin_amdgcn_mfma_f32_32x32x16_bf16((a), (b), (c), 0, 0, 0)
__device__ __forceinline__ unsigned pk_bf16(float lo, float hi) { typedef float f2_t __attribute__((ext_vector_type(2))); typedef __bf16 b2_t __attribute__((ext_vector_type(2)));
    f2_t v = {lo, hi}; b2_t b = __builtin_convertvector(v, b2_t); return __builtin_bit_cast(unsigned, b); }
__device__ __forceinline__ float bf_lo(unsigned w) { return __uint_as_float(w << 16); }
__device__ __forceinline__ float bf_hi(unsigned w) { return __uint_as_float(w & 0xffff0000u); }
__device__ __forceinline__ float wave_sum(float v) {
#pragma unroll
    for (int o = 1; o < 64; o <<= 1) v += __shfl_xor(v, o);
    return v;
}
__device__ __forceinline__ bf16x8 pack8(const f32x16& p, int s) {
    u32x4 w; w.x = pk_bf16(p[8 * s], p[8 * s + 1]); w.y = pk_bf16(p[8 * s + 2], p[8 * s + 3]); w.z = pk_bf16(p[8 * s + 4], p[8 * s + 5]); w.w = pk_bf16(p[8 * s + 6], p[8 * s + 7]);
    return __builtin_bit_cast(bf16x8, w);
}

__device__ __forceinline__ int win_dest_row(int n) {
    if (n < 1024) return n;
    if (n < 1536) return 1792 + (n - 1024);
    if (n < 2176) { const int base = n < 2048 ? 1024 : 1536, rel = n - (n < 2048 ? 1536 : 2048), hd = rel >> 6, d = rel & 63;
        return base + hd * 64 + 2 * (d & 31) + (d >> 5); }
    return 1664 + (n - 2176);
}
template <int MODE> __device__ __forceinline__ void transpose_item(const float* W, int K, int N, const float* gain, const float* gain2, bf16* WT, LAS float* scr, int item, int lane) {
    const int nblk = N / 32, kb = item / nblk, nb = item % nblk, k0 = 64 * kb, n0 = 32 * nb;
#pragma unroll 8
    for (int i = 0; i < 32; ++i) { const int kk = 2 * i + (lane >> 5), k = k0 + kk;
        float g = 1.0f; if (gain) g = (gain2 && k >= 512) ? gain2[k - 512] : gain[k];
        scr[kk * 33 + (lane & 31)] = W[(size_t)k * N + n0 + (lane & 31)] * g; }
    asm volatile("s_waitcnt lgkmcnt(0)" ::: "memory");
    const int c = lane & 7;
#pragma unroll
    for (int j = 0; j < 4; ++j) { const int n = (lane >> 3) + 8 * j; const LAS float* s = scr + (8 * c) * 33 + n;
        u32x4 o; o.x = pk_bf16(s[0 * 33], s[1 * 33]); o.y = pk_bf16(s[2 * 33], s[3 * 33]); o.z = pk_bf16(s[4 * 33], s[5 * 33]); o.w = pk_bf16(s[6 * 33], s[7 * 33]);
        const int dr = MODE == 1 ? win_dest_row(n0 + n) : (n0 + n);
        *(u32x4*)(WT + (size_t)dr * K + k0 + 8 * c) = o; }
    asm volatile("s_waitcnt lgkmcnt(0)" ::: "memory");
}

struct Args {
    const float* x; const int* pos; const float* attn_norm; const float* w_in; const float* sb_norm; const float* swa_norm; const float* sinks; const float* w_out;
    const float* mlp_norm; const float* w_up; const float* w_down; const float* final_norm; float* out; unsigned char* ws;
    int ph_lo, ph_hi;
};

__device__ __forceinline__ void prologue(const Args& a, LAS unsigned char* lds, int vcu, int G, int wave, int lane) {
    LAS float* scr = (LAS float*)(lds + wave * 16384);
    const int gw = vcu * NWAVES + wave, NGW = G * NWAVES;
    constexpr int I_IN = (DM / 64) * (INW / 32), I_OUT = (DM / 64) * (DM / 32), I_UP = (DM / 64) * (DFF / 32), I_DN = (DFF / 64) * (DM / 32), I_LAYER = I_IN + I_OUT + I_UP + I_DN;
    for (int it = gw; it < DEPTH * I_LAYER; it += NGW) {
        const int l = it / I_LAYER; int r = it % I_LAYER;
        bf16* wl = (bf16*)(a.ws + WS_W + (size_t)l * W_LAYER);
        if (r < I_IN) { transpose_item<1>(a.w_in + (size_t)l * DM * INW, DM, INW, a.attn_norm + l * DM, nullptr, (bf16*)((unsigned char*)wl + W_IN), scr, r, lane); continue; } r -= I_IN;
        if (r < I_OUT) { transpose_item<0>(a.w_out + (size_t)l * DM * DM, DM, DM, a.sb_norm + l * 512, a.swa_norm + l * 512, (bf16*)((unsigned char*)wl + W_OUT), scr, r, lane); continue; } r -= I_OUT;
        if (r < I_UP) { transpose_item<0>(a.w_up + (size_t)l * DM * DFF, DM, DFF, a.mlp_norm + l * DM, nullptr, (bf16*)((unsigned char*)wl + W_UP), scr, r, lane); continue; } r -= I_UP;
        transpose_item<0>(a.w_down + (size_t)l * DFF * DM, DFF, DM, nullptr, nullptr, (bf16*)((unsigned char*)wl + W_DOWN), scr, r, lane);
    }
    float* ssq = (float*)(a.ws + WS_SSQ); bf16* XB = (bf16*)(a.ws + WS_XB);
    for (int m = gw; m < MTOK; m += NGW) {
        const f32x4* xr = (const f32x4*)(a.x + (size_t)m * DM) + lane; unsigned long long* o8 = (unsigned long long*)(XB + (size_t)m * DM) + lane;
        float s = 0.f;
#pragma unroll
        for (int j = 0; j < 4; ++j) { const f32x4 v = xr[64 * j]; s += (v[0] * v[0] + v[1] * v[1]) + (v[2] * v[2] + v[3] * v[3]);
            o8[64 * j] = (unsigned long long)pk_bf16(v[0], v[1]) | ((unsigned long long)pk_bf16(v[2], v[3]) << 32); }
        s = wave_sum(s);
        if (lane == 0) ssq[m] = s;
        if (lane >= 1 && lane <= 4) ssq[(size_t)lane * MTOK + m] = 0.f;
    }
    { float* misc = (float*)(a.ws + WS_MISC); const int gt = gw * 64 + lane; if (gt < DEPTH * 8) misc[gt] = a.sinks[gt]; if (gt < DM) misc[1024 + gt] = a.final_norm[gt]; }
    float* rope = (float*)(a.ws + WS_ROPE);
    for (int idx = gw * 64 + lane; idx < SEQ * 32; idx += NGW * 64) {
        const int s = idx >> 5, i = idx & 31;
        const float invf = 1.0f / __builtin_amdgcn_exp2f((float)i * (13.287712379549449f / 32.0f));
        const float ang = (float)a.pos[s] * invf;
        const double rev = (double)ang * 0.15915494309189535; const float fr = (float)(rev - floor(rev));
        rope[2 * idx] = __builtin_amdgcn_cosf(fr); rope[2 * idx + 1] = __builtin_amdgcn_sinf(fr);
    }
}

constexpr int KP = 72, TILEB = 64 * KP * 2;

__device__ __forceinline__ void sb_unit(LAS unsigned char* lds, const bf16* PA, const bf16* VT, bf16* MIX, int b, int h, int qb) {
    int tid_l = threadIdx.x; asm volatile("" : "+v"(tid_l));
    const int tid = tid_l, lane = tid & 63, wid = __builtin_amdgcn_readfirstlane(tid >> 6), r32 = lane & 31, hi = lane >> 5;
    const int q0 = qb * 256, qw = q0 + wid * 32, qrow = qw + r32; const size_t tokbase = (size_t)b * SEQ;
    bf16x8 qr[4];
    { const bf16* Qp = PA + (tokbase + qrow) * NPA + h * 64 + hi * 8;
#pragma unroll
      for (int ds = 0; ds < 4; ++ds) qr[ds] = *(const bf16x8*)(Qp + 16 * ds); }
    const int lrow = tid >> 3, lch = tid & 7;
    const bf16* kg = PA + (tokbase + lrow) * NPA + 512 + h * 64 + lch * 8;
    const bf16* vg = VT + (size_t)(h * 64 + lrow) * MTOK + tokbase + lch * 8;
    const int lds_st = (lrow * KP + lch * 8) * 2;
    const int NT = (q0 + 256) / 64;
    u32x4 kreg = *(const u32x4*)(kg + (size_t)(NT - 1) * 64 * NPA), vreg = *(const u32x4*)(vg + (NT - 1) * 64);
    *(LAS u32x4*)(lds + lds_st) = kreg; *(LAS u32x4*)(lds + 2 * TILEB + lds_st) = vreg;
    __syncthreads();
    const int kp = 16 * ((r32 >> 2) & 1) + (r32 & 3) + 4 * (r32 >> 3);
    const int ka_off = (kp * KP + 8 * hi) * 2, va_off = (r32 * KP + 16 * hi) * 2;
    f32x16 o0, o1;
#pragma unroll
    for (int r = 0; r < 16; ++r) { o0[r] = 0.f; o1[r] = 0.f; }
    float C = 0.f;
    int cur = 0;
    for (int t = NT - 1; t >= 0; --t) {
        if (t > 0) { kreg = *(const u32x4*)(kg + (size_t)(t - 1) * 64 * NPA); vreg = *(const u32x4*)(vg + (t - 1) * 64); }
        const int k0 = t * 64;
        if (k0 < qw + 31) {
            LAS unsigned char* kb = lds + cur * TILEB; LAS unsigned char* vb = lds + 2 * TILEB + cur * TILEB;
            f32x16 p0, p1;
#pragma unroll
            for (int r = 0; r < 16; ++r) { p0[r] = 0.f; p1[r] = 0.f; }
#pragma unroll
            for (int ds = 0; ds < 4; ++ds) { const bf16x8 a0 = *(const LAS bf16x8*)(kb + ka_off + ds * 32), a1 = *(const LAS bf16x8*)(kb + ka_off + 32 * KP * 2 + ds * 32);
                p0 = MFMA32(a0, qr[ds], p0); p1 = MFMA32(a1, qr[ds], p1); }
            if (k0 + 63 >= qw) { const int kb0 = k0 + 16 * hi;
#pragma unroll
                for (int r = 0; r < 16; ++r) { if (kb0 + r >= qrow) p0[r] = -INFINITY; if (kb0 + 32 + r >= qrow) p1[r] = -INFINITY; } }
            f32x16 m0, m1; float T0 = 0.f, T1 = 0.f;
#pragma unroll
            for (int r = 0; r < 16; ++r) {
                { const float z = p0[r], e = __builtin_amdgcn_exp2f(-__builtin_fabsf(z)), tt = __builtin_amdgcn_logf(1.0f + e); m0[r] = -(__builtin_fmaxf(z, 0.f) + tt); T0 += m0[r]; }
                { const float z = p1[r], e = __builtin_amdgcn_exp2f(-__builtin_fabsf(z)), tt = __builtin_amdgcn_logf(1.0f + e); m1[r] = -(__builtin_fmaxf(z, 0.f) + tt); T1 += m1[r]; }
            }
            const float PT0 = __shfl_xor(T0, 32), PT1 = __shfl_xor(T1, 32);
            float s1 = C + (hi ? 0.f : PT1), s0 = C + T1 + PT1 + (hi ? 0.f : PT0);
            C += (T0 + T1) + (PT0 + PT1);
#pragma unroll
            for (int r = 15; r >= 0; --r) { p1[r] = __builtin_amdgcn_exp2f(p1[r] + m1[r] + s1); s1 += m1[r]; }
#pragma unroll
            for (int r = 15; r >= 0; --r) { p0[r] = __builtin_amdgcn_exp2f(p0[r] + m0[r] + s0); s0 += m0[r]; }
#pragma unroll
            for (int s = 0; s < 2; ++s) {
                { const bf16x8 pf = pack8(p0, s); const bf16x8 v0 = *(const LAS bf16x8*)(vb + va_off + (8 * s) * 2), v1 = *(const LAS bf16x8*)(vb + va_off + 32 * KP * 2 + (8 * s) * 2);
                  o0 = MFMA32(v0, pf, o0); o1 = MFMA32(v1, pf, o1); }
                { const bf16x8 pf = pack8(p1, s); const bf16x8 v0 = *(const LAS bf16x8*)(vb + va_off + (32 + 8 * s) * 2), v1 = *(const LAS bf16x8*)(vb + va_off + 32 * KP * 2 + (32 + 8 * s) * 2);
                  o0 = MFMA32(v0, pf, o0); o1 = MFMA32(v1, pf, o1); }
            }
        }
        if (t > 0) { *(LAS u32x4*)(lds + (cur ^ 1) * TILEB + lds_st) = kreg; *(LAS u32x4*)(lds + 2 * TILEB + (cur ^ 1) * TILEB + lds_st) = vreg; }
        __syncthreads(); cur ^= 1;
    }
    bf16* Op = MIX + (tokbase + qrow) * DM + h * 64 + 4 * hi;
#pragma unroll
    for (int g4 = 0; g4 < 4; ++g4) {
        u32x2 w0, w1; w0.x = pk_bf16(o0[4 * g4], o0[4 * g4 + 1]); w0.y = pk_bf16(o0[4 * g4 + 2], o0[4 * g4 + 3]); w1.x = pk_bf16(o1[4 * g4], o1[4 * g4 + 1]); w1.y = pk_bf16(o1[4 * g4 + 2], o1[4 * g4 + 3]);
        *(u32x2*)(Op + 8 * g4) = w0; *(u32x2*)(Op + 32 + 8 * g4) = w1; }
}

__device__ __forceinline__ void swa_unit(LAS unsigned char* lds, const bf16* PA, bf16* MIX, const float* sinks, int b, int kvh, int qblk) {
    int tid_l = threadIdx.x; asm volatile("" : "+v"(tid_l));
    const int tid = tid_l, lane = tid & 63, wid = __builtin_amdgcn_readfirstlane(tid >> 6), r32 = lane & 31, hi = lane >> 5;
    const int g = wid & 3, rh = wid >> 2, hq = kvh * 4 + g, q0 = qblk * 64, qw = q0 + rh * 32, qrow = qw + r32; const size_t tokbase = (size_t)b * SEQ;
    const int lrow = tid >> 3, lch = tid & 7; const int lds_st = (lrow * KP + lch * 8) * 2;
#pragma unroll
    for (int j = 0; j < 3; ++j) { int key = q0 - 128 + 64 * j + lrow; key = key < 0 ? 0 : key;
        const bf16* rp = PA + (tokbase + key) * NPA + kvh * 64 + lch * 8;
        const u32x4 kreg = *(const u32x4*)(rp + 1536), vreg = *(const u32x4*)(rp + 1664);
        *(LAS u32x4*)(lds + j * TILEB + lds_st) = kreg;
        LAS unsigned short* vt = (LAS unsigned short*)(lds + (3 + j) * TILEB) + (lch * 8) * KP + lrow;
        vt[0 * KP] = (unsigned short)(vreg.x & 0xffffu); vt[1 * KP] = (unsigned short)(vreg.x >> 16); vt[2 * KP] = (unsigned short)(vreg.y & 0xffffu); vt[3 * KP] = (unsigned short)(vreg.y >> 16);
        vt[4 * KP] = (unsigned short)(vreg.z & 0xffffu); vt[5 * KP] = (unsigned short)(vreg.z >> 16); vt[6 * KP] = (unsigned short)(vreg.w & 0xffffu); vt[7 * KP] = (unsigned short)(vreg.w >> 16); }
    bf16x8 qr[4];
    { const bf16* Qp = PA + (tokbase + qrow) * NPA + 1024 + hq * 64 + hi * 8;
#pragma unroll
      for (int ds = 0; ds < 4; ++ds) qr[ds] = *(const bf16x8*)(Qp + 16 * ds); }
    const float sink2 = sinks[hq] * 1.4426950408889634f;
    __syncthreads();
    const int kp = 16 * ((r32 >> 2) & 1) + (r32 & 3) + 4 * (r32 >> 3);
    const int ka_off = (kp * KP + 8 * hi) * 2, va_off = (r32 * KP + 16 * hi) * 2;
    f32x16 p[3][2];
#pragma unroll
    for (int j = 0; j < 3; ++j) {
#pragma unroll
        for (int r = 0; r < 16; ++r) { p[j][0][r] = 0.f; p[j][1][r] = 0.f; }
#pragma unroll
        for (int ds = 0; ds < 4; ++ds) { const bf16x8 a0 = *(const LAS bf16x8*)(lds + j * TILEB + ka_off + ds * 32), a1 = *(const LAS bf16x8*)(lds + j * TILEB + ka_off + 32 * KP * 2 + ds * 32);
            p[j][0] = MFMA32(a0, qr[ds], p[j][0]); p[j][1] = MFMA32(a1, qr[ds], p[j][1]); }
    }
    float mx = sink2;
#pragma unroll
    for (int j = 0; j < 3; ++j)
#pragma unroll
        for (int g2 = 0; g2 < 2; ++g2)
#pragma unroll
            for (int r = 0; r < 16; ++r) { const int key = q0 - 128 + 64 * j + 32 * g2 + 16 * hi + r; const int df = qrow - key;
                const bool valid = (key >= 0) && (df >= 0) && (df < 128);
                const float v = valid ? p[j][g2][r] : -INFINITY; p[j][g2][r] = v; mx = __builtin_fmaxf(mx, v); }
    mx = __builtin_fmaxf(mx, __shfl_xor(mx, 32));
    float sum = 0.f;
#pragma unroll
    for (int j = 0; j < 3; ++j)
#pragma unroll
        for (int g2 = 0; g2 < 2; ++g2)
#pragma unroll
            for (int r = 0; r < 16; ++r) { const float e = __builtin_amdgcn_exp2f(p[j][g2][r] - mx); p[j][g2][r] = e; sum += e; }
    sum += __shfl_xor(sum, 32); sum += __builtin_amdgcn_exp2f(sink2 - mx);
    f32x16 o0, o1;
#pragma unroll
    for (int r = 0; r < 16; ++r) { o0[r] = 0.f; o1[r] = 0.f; }
#pragma unroll
    for (int j = 0; j < 3; ++j)
#pragma unroll
        for (int g2 = 0; g2 < 2; ++g2)
#pragma unroll
            for (int s = 0; s < 2; ++s) { const bf16x8 pf = pack8(p[j][g2], s); LAS unsigned char* vb = lds + (3 + j) * TILEB + va_off + (32 * g2 + 8 * s) * 2;
                const bf16x8 v0 = *(const LAS bf16x8*)(vb), v1 = *(const LAS bf16x8*)(vb + 32 * KP * 2);
                o0 = MFMA32(v0, pf, o0); o1 = MFMA32(v1, pf, o1); }
    const float inv = 1.0f / sum;
    bf16* Op = MIX + (tokbase + qrow) * DM + 512 + hq * 64 + 4 * hi;
#pragma unroll
    for (int g4 = 0; g4 < 4; ++g4) {
        u32x2 w0, w1; w0.x = pk_bf16(o0[4 * g4] * inv, o0[4 * g4 + 1] * inv); w0.y = pk_bf16(o0[4 * g4 + 2] * inv, o0[4 * g4 + 3] * inv);
        w1.x = pk_bf16(o1[4 * g4] * inv, o1[4 * g4 + 1] * inv); w1.y = pk_bf16(o1[4 * g4 + 2] * inv, o1[4 * g4 + 3] * inv);
        *(u32x2*)(Op + 8 * g4) = w0; *(u32x2*)(Op + 32 + 8 * g4) = w1; }
    __syncthreads();
}

__global__ void __launch_bounds__(NWAVES * 64, 2) fwd_megakernel(Args a) {
    extern __shared__ __attribute__((aligned(16))) unsigned char lds_raw[];
    LAS unsigned char* lds = (LAS unsigned char*)lds_raw;
    cg::grid_group grid = cg::this_grid();
    const int tid = threadIdx.x, lane = tid & 63, wave = __builtin_amdgcn_readfirstlane(tid >> 6);
    const int G = gridDim.x, bx = blockIdx.x, vcu = (G % 8 == 0) ? (bx % 8) * (G / 8) + bx / 8 : bx;
    const int gw = vcu * NWAVES + wave, NGW = G * NWAVES;
    unsigned char* ws = a.ws;
    float* ssq = (float*)(ws + WS_SSQ); const float* rope = (const float*)(ws + WS_ROPE);
    bf16* XB = (bf16*)(ws + WS_XB); bf16* MIX = (bf16*)(ws + WS_MIX); bf16* H = (bf16*)(ws + WS_H); bf16* PA = (bf16*)(ws + WS_PA); bf16* VT = (bf16*)(ws + WS_VT);
    const int lo = a.ph_lo, hi = a.ph_hi;
    int ph = 0;
#define PHASE_BEGIN if (ph >= lo && ph < hi) {
#define PHASE_END   if (ph + 1 < hi) grid.sync(); } ++ph;

    PHASE_BEGIN
#ifndef NO_PRO
    prologue(a, lds, vcu, G, wave, lane);
#endif
    PHASE_END

    for (int l = 0; l < DEPTH; ++l) {
        const unsigned char* wl = ws + WS_W + (size_t)l * W_LAYER;
        const bf16* Win_t = (const bf16*)(wl + W_IN); const bf16* Wout_t = (const bf16*)(wl + W_OUT); const bf16* Wup_t = (const bf16*)(wl + W_UP); const bf16* Wdown_t = (const bf16*)(wl + W_DOWN);
        const float* ssqA = ssq + (size_t)(2 * l) * MTOK; float* ssqB = ssq + (size_t)(2 * l + 1) * MTOK; float* ssqAn = ssq + (size_t)(2 * l + 2) * MTOK;
        PHASE_BEGIN
#ifndef NO_G1
            { pg8::Gemm g{XB, Win_t, MTOK, NPA, DM}; pg8::StaticOrder S; S.init(MTOK, NPA, G, bx);
              pg8::EpiProj E{PA, ssqA, rope}; pg8::gemm_phase<pg8::EpiProj, pg8::StaticOrder, true, true>(lds, g, S, E); }
#endif
#ifndef NO_G2
            { pg8::Gemm g{Win_t + (size_t)NPA * DM, XB, 512, MTOK, DM}; pg8::StaticOrder S; S.init(512, MTOK, G, bx);
              pg8::EpiVT E{VT, ssqA, MTOK}; pg8::gemm_phase<pg8::EpiVT, pg8::StaticOrder, true, true>(lds, g, S, E); }
#endif
        PHASE_END
        PHASE_BEGIN
            for (int i = vcu; i < 1024; i += G) { const int v = i & 255, rd = i >> 8, bh = v >> 2, s = v & 3; const int qb = rd == 0 ? s : rd == 1 ? 7 - s : rd == 2 ? 8 + s : 15 - s;
#ifndef NO_SB
                sb_unit(lds, PA, VT, MIX, bh >> 3, bh & 7, qb);
#endif
            }
#ifndef NO_SWA
            for (int i = vcu; i < 1024; i += G) swa_unit(lds, PA, MIX, (const float*)(ws + WS_MISC) + l * 8, i >> 7, (i >> 6) & 1, i & 63);
#endif
        PHASE_END
        PHASE_BEGIN
            for (int m = gw; m < MTOK; m += NGW) { u32x4* rp = (u32x4*)(MIX + (size_t)m * DM) + lane;
#pragma unroll
                for (int hgrp = 0; hgrp < 2; ++hgrp) { const u32x4 w = rp[64 * hgrp];
                    const float f0 = bf_lo(w.x), f1 = bf_hi(w.x), f2 = bf_lo(w.y), f3 = bf_hi(w.y), f4 = bf_lo(w.z), f5 = bf_hi(w.z), f6 = bf_lo(w.w), f7 = bf_hi(w.w);
                    const float ss = wave_sum((f0 * f0 + f1 * f1) + (f2 * f2 + f3 * f3) + (f4 * f4 + f5 * f5) + (f6 * f6 + f7 * f7));
                    const float rs = __builtin_amdgcn_rsqf(ss * (1.0f / 512.0f) + RMS_EPS);
                    u32x4 o; o.x = pk_bf16(f0 * rs, f1 * rs); o.y = pk_bf16(f2 * rs, f3 * rs); o.z = pk_bf16(f4 * rs, f5 * rs); o.w = pk_bf16(f6 * rs, f7 * rs);
                    rp[64 * hgrp] = o; } }
        PHASE_END
        PHASE_BEGIN
#ifndef NO_G3
            { pg8::Gemm g{MIX, Wout_t, MTOK, DM, DM}; pg8::StaticOrder S; S.init(MTOK, DM, G, bx);
              pg8::EpiRes E{l == 0 ? a.x : a.out, a.out, XB, ssqB}; pg8::gemm_phase<pg8::EpiRes, pg8::StaticOrder, true, true>(lds, g, S, E); }
#endif
        PHASE_END
        PHASE_BEGIN
#ifndef NO_G4
            { pg8::Gemm g{XB, Wup_t, MTOK, DFF, DM}; pg8::StaticOrder S; S.init(MTOK, DFF, G, bx);
              pg8::EpiUp E{H, ssqB, DFF}; pg8::gemm_phase<pg8::EpiUp, pg8::StaticOrder, true, true>(lds, g, S, E); }
#endif
        PHASE_END
        PHASE_BEGIN
#ifndef NO_G5
            { pg8::Gemm g{H, Wdown_t, MTOK, DM, DFF}; pg8::StaticOrder S; S.init(MTOK, DM, G, bx);
              pg8::EpiRes E{a.out, a.out, XB, ssqAn}; pg8::gemm_phase<pg8::EpiRes, pg8::StaticOrder, true, true>(lds, g, S, E); }
#endif
        PHASE_END
    }
    PHASE_BEGIN
        const float* ssqF = ssq + (size_t)(2 * DEPTH) * MTOK;
        for (int m = gw; m < MTOK; m += NGW) { f32x4* xr = (f32x4*)(a.out + (size_t)m * DM) + lane; const float rs = __builtin_amdgcn_rsqf(ssqF[m] * (1.0f / 1024.0f) + RMS_EPS);
#pragma unroll
            for (int j = 0; j < 4; ++j) { const f32x4 gq = *((const f32x4*)(ws + WS_MISC + 4096) + lane + 64 * j); xr[64 * j] = xr[64 * j] * rs * gq; } }
    PHASE_END
#undef PHASE_BEGIN
#undef PHASE_END
}

#ifndef MK_SPLIT
#define MK_SPLIT 0
#endif
constexpr int N_PHASES = 1 + 6 * DEPTH + 1;
extern "C" void kernel_launch(void* const* d_in, const int* in_sizes, int n_in, void* d_out, int out_size, void* d_ws, size_t ws_size, hipStream_t stream) {
    static int grid = 0;
    if (grid == 0) {
        if (n_in != 12 || in_sizes[0] != MTOK * DM || out_size != MTOK * DM || ws_size < WS_END) { fprintf(stderr, "kernel_launch: unexpected shapes (n_in %d, in0 %d, out %d, ws %zu); nothing launched\n", n_in, n_in > 0 ? in_sizes[0] : -1, out_size, ws_size); grid = -1; return; }
        int dev = 0, cus = 0, per_cu = 0;
        if (hipGetDevice(&dev) != hipSuccess || hipDeviceGetAttribute(&cus, hipDeviceAttributeMultiprocessorCount, dev) != hipSuccess) { grid = -1; return; }
        if (hipFuncSetAttribute((const void*)fwd_megakernel, hipFuncAttributeMaxDynamicSharedMemorySize, LDS_BYTES) != hipSuccess) { fprintf(stderr, "kernel_launch: hipFuncSetAttribute failed\n"); grid = -1; return; }
        if (hipOccupancyMaxActiveBlocksPerMultiprocessor(&per_cu, (const void*)fwd_megakernel, NWAVES * 64, LDS_BYTES) != hipSuccess || per_cu < 1) { fprintf(stderr, "kernel_launch: occupancy query says %d blocks per CU\n", per_cu); per_cu = 1; }
        (void)hipGetLastError();
        grid = cus;
    }
    if (grid < 0) return;
    Args a{};
    a.x = (const float*)d_in[0]; a.pos = (const int*)d_in[1]; a.attn_norm = (const float*)d_in[2]; a.w_in = (const float*)d_in[3]; a.sb_norm = (const float*)d_in[4]; a.swa_norm = (const float*)d_in[5];
    a.sinks = (const float*)d_in[6]; a.w_out = (const float*)d_in[7]; a.mlp_norm = (const float*)d_in[8]; a.w_up = (const float*)d_in[9]; a.w_down = (const float*)d_in[10]; a.final_norm = (const float*)d_in[11];
    a.out = (float*)d_out; a.ws = (unsigned char*)d_ws;
#if MK_SPLIT
    for (int p = 0; p < N_PHASES; ++p) { a.ph_lo = p; a.ph_hi = p + 1; hipLaunchKernelGGL(fwd_megakernel, dim3(grid), dim3(NWAVES * 64), LDS_BYTES, stream, a); }
#else
    a.ph_lo = 0; a.ph_hi = N_PHASES;
    void* args[] = {&a};
    hipError_t e = hipLaunchCooperativeKernel((const void*)fwd_megakernel, dim3(grid), dim3(NWAVES * 64), args, LDS_BYTES, stream);
    if (e != hipSuccess) fprintf(stderr, "kernel_launch: cooperative launch failed: %s (grid %d)\n", hipGetErrorString(e), grid);
#endif
}
```

```cpp
#include <hip/hip_runtime.h>
#include <hip/hip_cooperative_groups.h>
#include <cstdio>
#include <cstdint>
#include <cmath>
namespace pg8 {
#define PG8_LAS __attribute__((address_space(3)))
typedef unsigned short bf16_t;
typedef short bf16x8 __attribute__((ext_vector_type(8)));
typedef float f32x4 __attribute__((ext_vector_type(4)));
typedef unsigned u32x4 __attribute__((ext_vector_type(4)));
constexpr int BM = 256, BK = 64, HALF = 128, HTB = HALF * BK * 2  , STAGE_BYTES = 8 * HTB, NXCD = 8, WGM = 8;

__host__ __device__ __forceinline__ int lds_byte(int r, int c) { const int st = (r >> 4) * 2 + (c >> 5), rr = r & 15, cc = c & 31, ob = rr * 64 + cc * 2; return st * 1024 + (ob ^ (((ob >> 9) & 1) << 5)); }
__host__ __device__ __forceinline__ void stage_rc(int b, int& R, int& C) { const int st = b / 1024, sb = b % 1024, swz = sb ^ (((sb >> 9) & 1) << 5); R = (st >> 1) * 16 + swz / 64; C = (st & 1) * 32 + (swz % 64) / 2; }
__host__ __device__ __forceinline__ int perm32(int rho) { const int n = rho >> 4, i = rho & 15; return 8 * (i >> 2) + 4 * n + (i & 3); }

struct Unit { int pm, pn; };
struct Gemm { const bf16_t* A; const bf16_t* Bt; int M, N, K; };

struct StaticOrder {
    int nM, nN, nwg, G, c;
    __host__ __device__ void init(int M, int N, int G_, int c_) { nM = M / BM; nN = N / BM; nwg = nM * nN; G = G_; c = c_; }
    __host__ __device__ bool next(int i, Unit& u) const {
        const long L = (long)i * G + c; if (L >= nwg) return false;
        int wgid = (int)L; { const int q = nwg / NXCD, r = nwg % NXCD, xcd = wgid % NXCD, off = wgid / NXCD; wgid = (xcd < r ? xcd * (q + 1) : r * (q + 1) + (xcd - r) * q) + off; }
        const int nig = WGM * nN, gid = wgid / nig, fm = gid * WGM, gsz = (nM - fm) < WGM ? (nM - fm) : WGM;
        u.pm = fm + ((wgid % nig) % gsz); u.pn = (wgid % nig) / gsz; return true;
    }
    __device__ __forceinline__ void a_ready(const Unit&) const {}
    __device__ __forceinline__ void done(const Unit&) const {}
};

__device__ __forceinline__ unsigned cvt_pk_bf16(float lo, float hi) { unsigned r; asm volatile("v_cvt_pk_bf16_f32 %0, %1, %2" : "=v"(r) : "v"(lo), "v"(hi)); return r; }
typedef float f32x2 __attribute__((ext_vector_type(2)));

typedef unsigned u32x2 __attribute__((ext_vector_type(2)));
constexpr float RMS_EPS = 1e-6f;
constexpr float QSCALE = 0.125f * 1.4426950408889634f;
constexpr int NPA = 1792;
struct EpiProj {
    static constexpr bool PERM = true, AFTER_DRAIN = false;
    bf16_t* O; const float* ssq; const float* rope;
    __device__ __forceinline__ void operator()(const f32x4 (&acc)[2][2][4][2], const Unit& u, int wr, int wc, int fr, int fq) const {
        const int row0 = u.pm * BM + wr * 64 + fr, col0 = u.pn * BM + wc * 32 + 8 * fq;
        const int pn = u.pn;
        const bool rope0 = (pn >= 4), rope1 = (pn == 4 || pn == 5);
        const float sc = (pn <= 1 || pn == 4 || pn == 5) ? QSCALE : 1.0f;
        const int i0 = ((wc * 32 + 8 * fq) & 63) >> 1;
#pragma unroll
        for (int ai = 0; ai < 2; ++ai)
#pragma unroll
            for (int m = 0; m < 4; ++m) {
                const int row = row0 + ai * HALF + m * 16;
                const float rs = __builtin_amdgcn_rsqf(ssq[row] * (1.0f / 1024.0f) + RMS_EPS) * sc;
                f32x4 cs0 = (f32x4){1.f, 0.f, 1.f, 0.f}, cs1 = cs0;
                if (rope0) { const f32x4* rp = (const f32x4*)(rope + ((size_t)(row & 4095) * 32 + i0) * 2); cs0 = rp[0]; cs1 = rp[1]; }
                bf16_t* rowp = O + (size_t)row * NPA + col0;
#pragma unroll
                for (int bj = 0; bj < 2; ++bj) {
                    f32x4 v0 = acc[ai][bj][m][0] * rs, v1 = acc[ai][bj][m][1] * rs;
                    if (bj == 0 ? rope0 : rope1) {
                        v0 = (f32x4){v0[0] * cs0[0] - v0[1] * cs0[1], v0[1] * cs0[0] + v0[0] * cs0[1], v0[2] * cs0[2] - v0[3] * cs0[3], v0[3] * cs0[2] + v0[2] * cs0[3]};
                        v1 = (f32x4){v1[0] * cs1[0] - v1[1] * cs1[1], v1[1] * cs1[0] + v1[0] * cs1[1], v1[2] * cs1[2] - v1[3] * cs1[3], v1[3] * cs1[2] + v1[2] * cs1[3]};
                    }
                    u32x4 w; w.x = cvt_pk_bf16(v0[0], v0[1]); w.y = cvt_pk_bf16(v0[2], v0[3]); w.z = cvt_pk_bf16(v1[0], v1[1]); w.w = cvt_pk_bf16(v1[2], v1[3]);
                    *(u32x4*)(rowp + bj * HALF) = w;
                }
            }
    }
};
struct EpiVT {
    static constexpr bool PERM = true, AFTER_DRAIN = false;
    bf16_t* O; const float* ssq; int ldc;
    __device__ __forceinline__ void operator()(const f32x4 (&acc)[2][2][4][2], const Unit& u, int wr, int wc, int fr, int fq) const {
        const int row0 = u.pm * BM + wr * 64 + fr, col0 = u.pn * BM + wc * 32 + 8 * fq;
        f32x4 rs[2][2];
#pragma unroll
        for (int bj = 0; bj < 2; ++bj)
#pragma unroll
            for (int n = 0; n < 2; ++n) { const f32x4 s = *(const f32x4*)(ssq + col0 + bj * HALF + 4 * n);
                rs[bj][n] = (f32x4){__builtin_amdgcn_rsqf(s[0] * (1.0f / 1024.0f) + RMS_EPS), __builtin_amdgcn_rsqf(s[1] * (1.0f / 1024.0f) + RMS_EPS),
                                    __builtin_amdgcn_rsqf(s[2] * (1.0f / 1024.0f) + RMS_EPS), __builtin_amdgcn_rsqf(s[3] * (1.0f / 1024.0f) + RMS_EPS)}; }
#pragma unroll
        for (int ai = 0; ai < 2; ++ai)
#pragma unroll
            for (int m = 0; m < 4; ++m) { bf16_t* rowp = O + (size_t)(row0 + ai * HALF + m * 16) * ldc + col0;
#pragma unroll
                for (int bj = 0; bj < 2; ++bj) { const f32x4 v0 = acc[ai][bj][m][0] * rs[bj][0], v1 = acc[ai][bj][m][1] * rs[bj][1];
                    u32x4 w; w.x = cvt_pk_bf16(v0[0], v0[1]); w.y = cvt_pk_bf16(v0[2], v0[3]); w.z = cvt_pk_bf16(v1[0], v1[1]); w.w = cvt_pk_bf16(v1[2], v1[3]);
                    *(u32x4*)(rowp + bj * HALF) = w; } }
    }
};
struct EpiRes {
    static constexpr bool PERM = true, AFTER_DRAIN = false;
    const float* res; float* out; bf16_t* xb; float* ssq_out;
    __device__ __forceinline__ void operator()(const f32x4 (&acc)[2][2][4][2], const Unit& u, int wr, int wc, int fr, int fq) const {
        const int row0 = u.pm * BM + wr * 64 + fr, col0 = u.pn * BM + wc * 32 + 8 * fq;
#pragma unroll
        for (int ai = 0; ai < 2; ++ai)
#pragma unroll
            for (int m = 0; m < 4; ++m) { const int row = row0 + ai * HALF + m * 16; const size_t off = (size_t)row * 1024 + col0; float ss = 0.f;
#pragma unroll
                for (int bj = 0; bj < 2; ++bj) {
                    const f32x4 v0 = acc[ai][bj][m][0] + *(const f32x4*)(res + off + bj * HALF), v1 = acc[ai][bj][m][1] + *(const f32x4*)(res + off + bj * HALF + 4);
                    *(f32x4*)(out + off + bj * HALF) = v0; *(f32x4*)(out + off + bj * HALF + 4) = v1;
                    ss += (v0[0] * v0[0] + v0[1] * v0[1]) + (v0[2] * v0[2] + v0[3] * v0[3]) + (v1[0] * v1[0] + v1[1] * v1[1]) + (v1[2] * v1[2] + v1[3] * v1[3]);
                    u32x4 w; w.x = cvt_pk_bf16(v0[0], v0[1]); w.y = cvt_pk_bf16(v0[2], v0[3]); w.z = cvt_pk_bf16(v1[0], v1[1]); w.w = cvt_pk_bf16(v1[2], v1[3]);
                    *(u32x4*)(xb + off + bj * HALF) = w; }
                ss += __shfl_xor(ss, 16); ss += __shfl_xor(ss, 32);
                if (fq == 0) atomicAdd(ssq_out + row, ss); }
    }
};
struct EpiUp {
    static constexpr bool PERM = true, AFTER_DRAIN = false;
    bf16_t* O; const float* ssq; int ldc;
    __device__ __forceinline__ void operator()(const f32x4 (&acc)[2][2][4][2], const Unit& u, int wr, int wc, int fr, int fq) const {
        const int row0 = u.pm * BM + wr * 64 + fr, col0 = u.pn * BM + wc * 32 + 8 * fq;
#pragma unroll
        for (int ai = 0; ai < 2; ++ai)
#pragma unroll
            for (int m = 0; m < 4; ++m) { const int row = row0 + ai * HALF + m * 16; const float rs = __builtin_amdgcn_rsqf(ssq[row] * (1.0f / 1024.0f) + RMS_EPS);
                bf16_t* rowp = O + (size_t)row * ldc + col0;
#pragma unroll
                for (int bj = 0; bj < 2; ++bj) { f32x4 v0 = acc[ai][bj][m][0] * rs, v1 = acc[ai][bj][m][1] * rs;
                    v0 = __builtin_elementwise_max(v0, (f32x4){0.f, 0.f, 0.f, 0.f}); v1 = __builtin_elementwise_max(v1, (f32x4){0.f, 0.f, 0.f, 0.f}); v0 = v0 * v0; v1 = v1 * v1;
                    u32x4 w; w.x = cvt_pk_bf16(v0[0], v0[1]); w.y = cvt_pk_bf16(v0[2], v0[3]); w.z = cvt_pk_bf16(v1[0], v1[1]); w.w = cvt_pk_bf16(v1[2], v1[3]);
                    *(u32x4*)(rowp + bj * HALF) = w; } }
    }
};

template <class Epi, class Sched, bool ALIGN_EPI = false, bool SP2 = false>
__device__ __forceinline__ void gemm_phase(PG8_LAS unsigned char* lds, const Gemm g, const Sched& S, const Epi& E) {
    int tid_l = threadIdx.x; asm volatile("" : "+v"(tid_l));
    const int tid = tid_l, wid = __builtin_amdgcn_readfirstlane(tid >> 6), lane = tid & 63, wr = wid >> 2, wc = wid & 3, fr = lane & 15, fq = lane >> 4;
    const int K = g.K, nt = K / BK;
    unsigned voffA[2], voffB[2];
#pragma unroll
    for (int i = 0; i < 2; ++i) { int R, C; stage_rc(tid * 16 + i * 8192, R, C); const int Rb = Epi::PERM ? ((R & ~31) + perm32(R & 31)) : R;
        voffA[i] = (unsigned)(R * K + C) * 2u; voffB[i] = (unsigned)(Rb * K + C) * 2u; }
    const size_t kstep = (size_t)(BK * 2);
    const size_t hstep = (size_t)HALF * K * 2;
    const size_t tstep = 2 * hstep;
    const unsigned ldsw = (unsigned)wid * 1024u;
    const int aoff = lds_byte(wr * 64 + fr, fq * 8), boff = lds_byte(wc * 32 + fr, fq * 8);
#define PG8_SA(b, h) (((b) * 2 + (h)) * HTB)
#define PG8_SB(b, h) ((4 + (b) * 2 + (h)) * HTB)
#define PG8_STAGE(bufoff, gbase, voff) do { _Pragma("unroll") for (int _i = 0; _i < 2; ++_i) \
        __builtin_amdgcn_global_load_lds((const unsigned*)((const char*)(gbase) + (voff)[_i]), (PG8_LAS unsigned*)(lds + (bufoff) + ldsw + _i * 8192), 16, 0, 0); } while (0)
#define PG8_LDA(dst, b, h) do { _Pragma("unroll") for (int m = 0; m < 4; ++m) _Pragma("unroll") for (int k = 0; k < 2; ++k) dst[m][k] = *(const PG8_LAS bf16x8*)(lds + PG8_SA(b, h) + aoff + m * 2048 + k * 1024); } while (0)
#define PG8_LDB(dst, b, h) do { _Pragma("unroll") for (int n = 0; n < 2; ++n) _Pragma("unroll") for (int k = 0; k < 2; ++k) dst[n][k] = *(const PG8_LAS bf16x8*)(lds + PG8_SB(b, h) + boff + n * 2048 + k * 1024); } while (0)
#define PG8_MMA(ai, bj, At, Bt) do { __builtin_amdgcn_s_setprio(1); _Pragma("unroll") for (int m = 0; m < 4; ++m) _Pragma("unroll") for (int n = 0; n < 2; ++n) _Pragma("unroll") for (int k = 0; k < 2; ++k) \
        acc[ai][bj][m][n] = __builtin_amdgcn_mfma_f32_16x16x32_bf16(Bt[n][k], At[m][k], acc[ai][bj][m][n], 0, 0, 0); __builtin_amdgcn_s_setprio(0); } while (0)
#define PG8_WAIT_V(n) asm volatile("s_waitcnt vmcnt(" #n ")" ::: "memory")
#define PG8_WAIT_L(n) asm volatile("s_waitcnt lgkmcnt(" #n ")" ::: "memory")
#define PG8_BAR __builtin_amdgcn_s_barrier()
#define PG8_SCHED __builtin_amdgcn_sched_barrier(0)
    Unit cur, nxt; int ui = 0;
    if (!S.next(0, cur)) return;
    f32x4 acc[2][2][4][2];
#pragma unroll
    for (int a = 0; a < 2; ++a)
#pragma unroll
        for (int b = 0; b < 2; ++b)
#pragma unroll
            for (int m = 0; m < 4; ++m)
#pragma unroll
                for (int n = 0; n < 2; ++n) acc[a][b][m][n] = (f32x4){0.f, 0.f, 0.f, 0.f};
    bf16x8 At[4][2], B0[2][2], B1[2][2];
    const char* cA = (const char*)g.A + (size_t)cur.pm * tstep; const char* cB = (const char*)g.Bt + (size_t)cur.pn * tstep;
    S.a_ready(cur);
    if constexpr (SP2) {
        PG8_STAGE(PG8_SB(0, 0), cB, voffB); PG8_STAGE(PG8_SB(0, 1), cB + hstep, voffB); PG8_STAGE(PG8_SA(0, 0), cA, voffA); PG8_STAGE(PG8_SA(0, 1), cA + hstep, voffA);
        if (wr == 1) PG8_BAR;
        PG8_WAIT_V(2); PG8_BAR;
        PG8_STAGE(PG8_SB(1, 0), cB + kstep, voffB); PG8_STAGE(PG8_SA(1, 0), cA + kstep, voffA); PG8_STAGE(PG8_SB(1, 1), cB + hstep + kstep, voffB);
        PG8_WAIT_V(6); PG8_BAR;
    } else {
        PG8_STAGE(PG8_SB(0, 0), cB, voffB); PG8_STAGE(PG8_SA(0, 0), cA, voffA); PG8_STAGE(PG8_SB(0, 1), cB + hstep, voffB); PG8_STAGE(PG8_SA(0, 1), cA + hstep, voffA);
        if (wr == 1) PG8_BAR;
        PG8_WAIT_V(4); PG8_BAR;
        PG8_STAGE(PG8_SB(1, 0), cB + kstep, voffB); PG8_STAGE(PG8_SA(1, 0), cA + kstep, voffA); PG8_STAGE(PG8_SB(1, 1), cB + hstep + kstep, voffB);
        PG8_WAIT_V(6); PG8_BAR;
    }
    for (;;) {
        const bool has_next = S.next(ui + 1, nxt);
        const char* nA = has_next ? (const char*)g.A + (size_t)nxt.pm * tstep : cA; const char* nB = has_next ? (const char*)g.Bt + (size_t)nxt.pn * tstep : cB;
        for (int t = 0; t < nt; t += 2) {
            const bool last = (t == nt - 2);
            const char* a1 = cA + (size_t)(t + 1) * kstep;
            const char* a2 = last ? nA : cA + (size_t)(t + 2) * kstep; const char* b2 = last ? nB : cB + (size_t)(t + 2) * kstep;
            const char* a3 = a2 + kstep; const char* b3 = b2 + kstep;
            if (last && has_next) S.a_ready(nxt);
            if constexpr (SP2) {
            PG8_LDB(B0, 0, 0); PG8_LDB(B1, 0, 1); PG8_SCHED; PG8_LDA(At, 0, 0); PG8_STAGE(PG8_SA(1, 1), a1 + hstep, voffA);
            PG8_WAIT_V(8); PG8_WAIT_L(0); PG8_BAR; PG8_MMA(0, 0, At, B0); PG8_MMA(0, 1, At, B1); PG8_BAR; PG8_SCHED;
            PG8_LDA(At, 0, 1); PG8_STAGE(PG8_SB(0, 0), b2, voffB); PG8_STAGE(PG8_SB(0, 1), b2 + hstep, voffB); PG8_STAGE(PG8_SA(0, 0), a2, voffA);
            PG8_WAIT_V(8); PG8_WAIT_L(0); PG8_BAR; PG8_MMA(1, 0, At, B0); PG8_MMA(1, 1, At, B1); PG8_BAR; PG8_SCHED;
            PG8_LDB(B0, 1, 0); PG8_LDB(B1, 1, 1); PG8_SCHED; PG8_LDA(At, 1, 0); PG8_STAGE(PG8_SA(0, 1), a2 + hstep, voffA);
            PG8_WAIT_V(8); PG8_WAIT_L(0); PG8_BAR; PG8_MMA(0, 0, At, B0); PG8_MMA(0, 1, At, B1); PG8_BAR; PG8_SCHED;
            PG8_LDA(At, 1, 1); PG8_STAGE(PG8_SB(1, 0), b3, voffB); PG8_STAGE(PG8_SB(1, 1), b3 + hstep, voffB); PG8_STAGE(PG8_SA(1, 0), a3, voffA);
            PG8_WAIT_V(8); PG8_WAIT_L(0); PG8_BAR; PG8_MMA(1, 0, At, B0); PG8_MMA(1, 1, At, B1); PG8_BAR; PG8_SCHED;
            } else {
            PG8_LDB(B0, 0, 0); PG8_SCHED; PG8_LDA(At, 0, 0); PG8_STAGE(PG8_SA(1, 1), a1 + hstep, voffA);
            PG8_WAIT_L(8); PG8_BAR; PG8_WAIT_L(0); PG8_MMA(0, 0, At, B0); PG8_BAR; PG8_SCHED;
            PG8_LDB(B1, 0, 1); PG8_STAGE(PG8_SB(0, 0), b2, voffB);
            PG8_BAR; PG8_WAIT_L(0); PG8_MMA(0, 1, At, B1); PG8_BAR;
            PG8_LDA(At, 0, 1); PG8_STAGE(PG8_SA(0, 0), a2, voffA);
            PG8_BAR; PG8_WAIT_L(0); PG8_MMA(1, 0, At, B0); PG8_BAR; PG8_SCHED;
            PG8_STAGE(PG8_SB(0, 1), b2 + hstep, voffB);
            PG8_WAIT_V(6); PG8_BAR; PG8_MMA(1, 1, At, B1); PG8_BAR;
            PG8_LDB(B0, 1, 0); PG8_SCHED; PG8_LDA(At, 1, 0); PG8_STAGE(PG8_SA(0, 1), a2 + hstep, voffA);
            PG8_WAIT_L(8); PG8_BAR; PG8_WAIT_L(0); PG8_MMA(0, 0, At, B0); PG8_BAR; PG8_SCHED;
            PG8_LDB(B1, 1, 1); PG8_STAGE(PG8_SB(1, 0), b3, voffB);
            PG8_BAR; PG8_WAIT_L(0); PG8_MMA(0, 1, At, B1); PG8_BAR;
            PG8_LDA(At, 1, 1); PG8_STAGE(PG8_SA(1, 0), a3, voffA);
            PG8_BAR; PG8_WAIT_L(0); PG8_MMA(1, 0, At, B0); PG8_BAR; PG8_SCHED;
            PG8_STAGE(PG8_SB(1, 1), b3 + hstep, voffB);
            PG8_WAIT_V(6); PG8_BAR; PG8_MMA(1, 1, At, B1); PG8_BAR;
            }
        }
        if constexpr (ALIGN_EPI) { if (wr == 0) PG8_BAR; }
        if constexpr (!Epi::AFTER_DRAIN) { E(acc, cur, wr, wc, fr, fq); S.done(cur); }
        if (!has_next) break;
#pragma unroll
        for (int a = 0; a < 2; ++a)
#pragma unroll
            for (int b = 0; b < 2; ++b)
#pragma unroll
                for (int m = 0; m < 4; ++m)
#pragma unroll
                    for (int n = 0; n < 2; ++n) acc[a][b][m][n] = (f32x4){0.f, 0.f, 0.f, 0.f};
        cur = nxt; cA = nA; cB = nB; ++ui;
        if constexpr (ALIGN_EPI) { if (wr == 1) PG8_BAR; }
    }
    PG8_WAIT_V(0);
    if constexpr (!ALIGN_EPI) { if (wr == 0) PG8_BAR; }
    PG8_BAR;
    if constexpr (Epi::AFTER_DRAIN) { E.fused(acc, cur, wr, wc, fr, fq, lds, wid, lane); S.done(cur); }
#undef PG8_SA
#undef PG8_SB
#undef PG8_STAGE
#undef PG8_LDA
#undef PG8_LDB
#undef PG8_MMA
#undef PG8_WAIT_V
#undef PG8_WAIT_L
#undef PG8_BAR
#undef PG8_SCHED
}
}

namespace cg = cooperative_groups;
#define LAS __attribute__((address_space(3)))
typedef unsigned short bf16;
typedef short bf16x8 __attribute__((ext_vector_type(8)));
typedef float f32x4 __attribute__((ext_vector_type(4)));
typedef float f32x16 __attribute__((ext_vector_type(16)));
typedef unsigned u32x4 __attribute__((ext_vector_type(4)));
typedef unsigned u32x2 __attribute__((ext_vector_type(2)));

constexpr int NWAVES = 8;
constexpr int BATCH = 8, SEQ = 4096, DM = 1024, MTOK = BATCH * SEQ, DFF = 4096, DEPTH = 2, INW = 2304;
constexpr int NPA = pg8::NPA;
constexpr float RMS_EPS = 1e-6f;
constexpr size_t MiB = 1u << 20;
constexpr size_t WS_BAR = 0;
constexpr size_t WS_SSQ = 1 * MiB;
constexpr size_t WS_MISC = 3 * MiB;
constexpr size_t WS_ROPE = 2 * MiB;
constexpr size_t WS_W = 4 * MiB;
constexpr size_t W_IN = 0, W_OUT = (size_t)INW * DM * 2, W_UP = W_OUT + (size_t)DM * DM * 2, W_DOWN = W_UP + (size_t)DFF * DM * 2, W_LAYER = W_DOWN + (size_t)DM * DFF * 2;
constexpr size_t WS_XB = 52 * MiB;
constexpr size_t WS_MIX = 116 * MiB;
constexpr size_t WS_H = 180 * MiB;
constexpr size_t WS_PA = 180 * MiB;
constexpr size_t WS_VT = 292 * MiB;
constexpr size_t WS_END = 436 * MiB;
static_assert(WS_W + DEPTH * W_LAYER <= WS_XB && WS_PA + (size_t)MTOK * NPA * 2 <= WS_VT && WS_VT + (size_t)512 * MTOK * 2 <= WS_END, "d_ws map");
constexpr int LDS_BYTES = 147456;

#define MFMA32(a, b, c) __builtin_amdgcn_mfma_f32_32x32x16_bf16((a), (b), (c), 0, 0, 0)
__device__ __forceinline__ unsigned pk_bf16(float lo, float hi) { typedef float f2_t __attribute__((ext_vector_type(2))); typedef __bf16 b2_t __attribute__((ext_vector_type(2)));
    f2_t v = {lo, hi}; b2_t b = __builtin_convertvector(v, b2_t); return __builtin_bit_cast(unsigned, b); }
__device__ __forceinline__ float bf_lo(unsigned w) { return __uint_as_float(w << 16); }
__device__ __forceinline__ float bf_hi(unsigned w) { return __uint_as_float(w & 0xffff0000u); }
__device__ __forceinline__ float wave_sum(float v) {
#pragma unroll
    for (int o = 1; o < 64; o <<= 1) v += __shfl_xor(v, o);
    return v;
}
__device__ __forceinline__ bf16x8 pack8(const f32x16& p, int s) {
    u32x4 w; w.x = pk_bf16(p[8 * s], p[8 * s + 1]); w.y = pk_bf16(p[8 * s + 2], p[8 * s + 3]); w.z = pk_bf16(p[8 * s + 4], p[8 * s + 5]); w.w = pk_bf16(p[8 * s + 6], p[8 * s + 7]);
    return __builtin_bit_cast(bf16x8, w);
}

#define XB_TMO      128
#define XB_XCNT(j)  (256  + 64 * (j))
#define XB_XSUB(j)  (1280 + 64 * (j))
#define XB_XGEN(j)  (2304 + 64 * (j))
#define XB_TOP      3328
#define XB_TOPGEN   3392
#define XCD_BAR_WORDS 3456
#define XB_SPIN_CAP (1u << 18)

__device__ __forceinline__ unsigned xb_ld(unsigned* p)              { return __hip_atomic_load(p, __ATOMIC_RELAXED, __HIP_MEMORY_SCOPE_AGENT); }
__device__ __forceinline__ unsigned xb_add(unsigned* p, unsigned v) { return __hip_atomic_fetch_add(p, v, __ATOMIC_RELAXED, __HIP_MEMORY_SCOPE_AGENT); }
__device__ __forceinline__ unsigned xb_xcc_id() { return (unsigned)__builtin_amdgcn_s_getreg((3 << 11) | 20) & 0xFu; }
#define XB_SPIN(cond, bar) do { unsigned _sp = 0; while (cond) { __builtin_amdgcn_s_sleep(1); \
    if ((++_sp & 255u) == 0u) { if (xb_ld(&(bar)[XB_TMO])) break; if (_sp > XB_SPIN_CAP) { atomicAdd(&(bar)[XB_TMO], 1u); break; } } } } while (0)

struct XcdBarrier {
    unsigned* bar; unsigned x;
    volatile LAS unsigned* st;
};

__device__ __forceinline__ XcdBarrier xcd_barrier_post(unsigned* bar, volatile LAS unsigned* st) {
    XcdBarrier b; b.bar = bar; b.x = xb_xcc_id(); b.st = st;
    if (threadIdx.x == 0) (void)xb_add(&bar[XB_XCNT(b.x)], 1u);
    return b;
}
__device__ __forceinline__ void xcd_barrier_complete(unsigned* bar, unsigned x, unsigned& nloc, unsigned& nx) {
    const unsigned G = gridDim.x * gridDim.y * gridDim.z;
    unsigned sum, cnt, mine, sp = 0u;
    for (;;) {
        sum = 0u; cnt = 0u; mine = 0u;
#pragma unroll
        for (unsigned j = 0; j < 16; ++j) { const unsigned c = xb_ld(&bar[XB_XCNT(j)]); sum += c; cnt += (c > 0u) ? 1u : 0u; mine = (j == x) ? c : mine; }
        if (sum == G) break;
        __builtin_amdgcn_s_sleep(1);
        if ((++sp & 255u) == 0u) { if (xb_ld(&bar[XB_TMO])) break; if (sp > XB_SPIN_CAP) { atomicAdd(&bar[XB_TMO], 1u); break; } }
    }
    nloc = mine > 0u ? mine : 1u; nx = cnt > 0u ? cnt : 1u;
}

__device__ __forceinline__ void xcd_barrier(const XcdBarrier& b) {
    asm volatile("s_waitcnt vmcnt(0)" ::: "memory");
    __syncthreads();
    if (threadIdx.x == 0) {
        unsigned* bar = b.bar;
        __builtin_amdgcn_s_waitcnt(0);
        unsigned nloc = b.st[0], nx = b.st[1];
        if (nloc == 0u) { xcd_barrier_complete(bar, b.x, nloc, nx); b.st[0] = nloc; b.st[1] = nx; }
        const unsigned old = xb_add(&bar[XB_XSUB(b.x)], 1u);
        const unsigned gen = old / nloc;
        if (old + 1u == (gen + 1u) * nloc) {
            __builtin_amdgcn_fence(__ATOMIC_RELEASE, "agent");
            asm volatile("s_waitcnt vmcnt(0)" ::: "memory");
            const unsigned og = xb_add(&bar[XB_TOP], 1u);
            const unsigned tg = og / nx;
            if (og + 1u == (tg + 1u) * nx) xb_add(&bar[XB_TOPGEN], 1u);
            else XB_SPIN(xb_ld(&bar[XB_TOPGEN]) == tg, bar);
            __builtin_amdgcn_fence(__ATOMIC_ACQUIRE, "agent");
            xb_add(&bar[XB_XGEN(b.x)], 1u);
            asm volatile("s_waitcnt vmcnt(0)" ::: "memory");
        } else {
            XB_SPIN(xb_ld(&bar[XB_XGEN(b.x)]) == gen, bar);
            __builtin_amdgcn_fence(__ATOMIC_ACQUIRE, "agent");
            asm volatile("s_waitcnt vmcnt(0)" ::: "memory");
        }
    }
    __syncthreads();
}

__device__ __forceinline__ int win_dest_row(int n) {
    if (n < 1024) return n;
    if (n < 1536) return 1792 + (n - 1024);
    if (n < 2176) { const int base = n < 2048 ? 1024 : 1536, rel = n - (n < 2048 ? 1536 : 2048), hd = rel >> 6, d = rel & 63;
        return base + hd * 64 + 2 * (d & 31) + (d >> 5); }
    return 1664 + (n - 2176);
}
template <int MODE> __device__ __forceinline__ void transpose_item(const float* W, int K, int N, const float* gain, const float* gain2, bf16* WT, LAS float* scr, int item, int lane) {
    const int nblk = N / 32, kb = item / nblk, nb = item % nblk, k0 = 64 * kb, n0 = 32 * nb;
#pragma unroll 8
    for (int i = 0; i < 32; ++i) { const int kk = 2 * i + (lane >> 5), k = k0 + kk;
        float g = 1.0f; if (gain) g = (gain2 && k >= 512) ? gain2[k - 512] : gain[k];
        scr[kk * 33 + (lane & 31)] = W[(size_t)k * N + n0 + (lane & 31)] * g; }
    asm volatile("s_waitcnt lgkmcnt(0)" ::: "memory");
    const int c = lane & 7;
#pragma unroll
    for (int j = 0; j < 4; ++j) { const int n = (lane >> 3) + 8 * j; const LAS float* s = scr + (8 * c) * 33 + n;
        u32x4 o; o.x = pk_bf16(s[0 * 33], s[1 * 33]); o.y = pk_bf16(s[2 * 33], s[3 * 33]); o.z = pk_bf16(s[4 * 33], s[5 * 33]); o.w = pk_bf16(s[6 * 33], s[7 * 33]);
        const int dr = MODE == 1 ? win_dest_row(n0 + n) : (n0 + n);
        *(u32x4*)(WT + (size_t)dr * K + k0 + 8 * c) = o; }
    asm volatile("s_waitcnt lgkmcnt(0)" ::: "memory");
}

struct Args {
    const float* x; const int* pos; const float* attn_norm; const float* w_in; const float* sb_norm; const float* swa_norm; const float* sinks; const float* w_out;
    const float* mlp_norm; const float* w_up; const float* w_down; const float* final_norm; float* out; unsigned char* ws;
    int ph_lo, ph_hi;
};

__device__ __forceinline__ void prologue(const Args& a, LAS unsigned char* lds, int vcu, int G, int wave, int lane) {
    LAS float* scr = (LAS float*)(lds + wave * 16384);
    const int gw = vcu * NWAVES + wave, NGW = G * NWAVES;
    if (blockIdx.x == 0) for (int i = threadIdx.x; i < XCD_BAR_WORDS; i += NWAVES * 64) ((unsigned*)(a.ws + WS_BAR))[i] = 0u;
    constexpr int I_IN = (DM / 64) * (INW / 32), I_OUT = (DM / 64) * (DM / 32), I_UP = (DM / 64) * (DFF / 32), I_DN = (DFF / 64) * (DM / 32), I_LAYER = I_IN + I_OUT + I_UP + I_DN;
    for (int it = gw; it < DEPTH * I_LAYER; it += NGW) {
        const int l = it / I_LAYER; int r = it % I_LAYER;
        bf16* wl = (bf16*)(a.ws + WS_W + (size_t)l * W_LAYER);
        if (r < I_IN) { transpose_item<1>(a.w_in + (size_t)l * DM * INW, DM, INW, a.attn_norm + l * DM, nullptr, (bf16*)((unsigned char*)wl + W_IN), scr, r, lane); continue; } r -= I_IN;
        if (r < I_OUT) { transpose_item<0>(a.w_out + (size_t)l * DM * DM, DM, DM, a.sb_norm + l * 512, a.swa_norm + l * 512, (bf16*)((unsigned char*)wl + W_OUT), scr, r, lane); continue; } r -= I_OUT;
        if (r < I_UP) { transpose_item<0>(a.w_up + (size_t)l * DM * DFF, DM, DFF, a.mlp_norm + l * DM, nullptr, (bf16*)((unsigned char*)wl + W_UP), scr, r, lane); continue; } r -= I_UP;
        transpose_item<0>(a.w_down + (size_t)l * DFF * DM, DFF, DM, nullptr, nullptr, (bf16*)((unsigned char*)wl + W_DOWN), scr, r, lane);
    }
    float* ssq = (float*)(a.ws + WS_SSQ); bf16* XB = (bf16*)(a.ws + WS_XB);
    for (int m = gw; m < MTOK; m += NGW) {
        const f32x4* xr = (const f32x4*)(a.x + (size_t)m * DM) + lane; unsigned long long* o8 = (unsigned long long*)(XB + (size_t)m * DM) + lane;
        float s = 0.f;
#pragma unroll
        for (int j = 0; j < 4; ++j) { const f32x4 v = xr[64 * j]; s += (v[0] * v[0] + v[1] * v[1]) + (v[2] * v[2] + v[3] * v[3]);
            o8[64 * j] = (unsigned long long)pk_bf16(v[0], v[1]) | ((unsigned long long)pk_bf16(v[2], v[3]) << 32); }
        s = wave_sum(s);
        if (lane == 0) ssq[m] = s;
        if (lane >= 1 && lane <= 4) ssq[(size_t)lane * MTOK + m] = 0.f;
    }
    { float* misc = (float*)(a.ws + WS_MISC); const int gt = gw * 64 + lane; if (gt < DEPTH * 8) misc[gt] = a.sinks[gt]; if (gt < DM) misc[1024 + gt] = a.final_norm[gt]; }
    float* rope = (float*)(a.ws + WS_ROPE);
    for (int idx = gw * 64 + lane; idx < SEQ * 32; idx += NGW * 64) {
        const int s = idx >> 5, i = idx & 31;
        const float invf = 1.0f / __builtin_amdgcn_exp2f((float)i * (13.287712379549449f / 32.0f));
        const float ang = (float)a.pos[s] * invf;
        const double rev = (double)ang * 0.15915494309189535; const float fr = (float)(rev - floor(rev));
        rope[2 * idx] = __builtin_amdgcn_cosf(fr); rope[2 * idx + 1] = __builtin_amdgcn_sinf(fr);
    }
}

constexpr int KP = 72, TILEB = 64 * KP * 2;

__device__ __forceinline__ void sb_unit(LAS unsigned char* lds, const bf16* PA, const bf16* VT, bf16* MIX, int b, int h, int qb) {
    int tid_l = threadIdx.x; asm volatile("" : "+v"(tid_l));
    const int tid = tid_l, lane = tid & 63, wid = __builtin_amdgcn_readfirstlane(tid >> 6), r32 = lane & 31, hi = lane >> 5;
    const int q0 = qb * 256, qw = q0 + wid * 32, qrow = qw + r32; const size_t tokbase = (size_t)b * SEQ;
    bf16x8 qr[4];
    { const bf16* Qp = PA + (tokbase + qrow) * NPA + h * 64 + hi * 8;
#pragma unroll
      for (int ds = 0; ds < 4; ++ds) qr[ds] = *(const bf16x8*)(Qp + 16 * ds); }
    const int lrow = tid >> 3, lch = tid & 7;
    const bf16* kg = PA + (tokbase + lrow) * NPA + 512 + h * 64 + lch * 8;
    const bf16* vg = VT + (size_t)(h * 64 + lrow) * MTOK + tokbase + lch * 8;
    const int lds_st = (lrow * KP + lch * 8) * 2;
    const int NT = (q0 + 256) / 64;
    u32x4 kreg = *(const u32x4*)(kg + (size_t)(NT - 1) * 64 * NPA), vreg = *(const u32x4*)(vg + (NT - 1) * 64);
    *(LAS u32x4*)(lds + lds_st) = kreg; *(LAS u32x4*)(lds + 2 * TILEB + lds_st) = vreg;
    volatile LAS unsigned* cnt = (volatile LAS unsigned*)(lds + 4 * TILEB);
    if (tid < 4) cnt[tid] = 0u;
    __syncthreads();
    const int kp = 16 * ((r32 >> 2) & 1) + (r32 & 3) + 4 * (r32 >> 3);
    const int ka_off = (kp * KP + 8 * hi) * 2, va_off = (r32 * KP + 16 * hi) * 2;
    f32x16 o0, o1;
#pragma unroll
    for (int r = 0; r < 16; ++r) { o0[r] = 0.f; o1[r] = 0.f; }
    float C = 0.f;
    int cur = 0, it = 0; bool wdone = false;
    for (int t = NT - 1; t >= 0; --t, ++it) {
        if (t > 0) { kreg = *(const u32x4*)(kg + (size_t)(t - 1) * 64 * NPA); vreg = *(const u32x4*)(vg + (t - 1) * 64); }
        const int k0 = t * 64;
        if (!wdone && k0 < qw + 31) {
            LAS unsigned char* kb = lds + cur * TILEB; LAS unsigned char* vb = lds + 2 * TILEB + cur * TILEB;
            f32x16 p0, p1;
#pragma unroll
            for (int r = 0; r < 16; ++r) { p0[r] = 0.f; p1[r] = 0.f; }
#pragma unroll
            for (int ds = 0; ds < 4; ++ds) { const bf16x8 a0 = *(const LAS bf16x8*)(kb + ka_off + ds * 32), a1 = *(const LAS bf16x8*)(kb + ka_off + 32 * KP * 2 + ds * 32);
                p0 = MFMA32(a0, qr[ds], p0); p1 = MFMA32(a1, qr[ds], p1); }
            if (k0 + 63 >= qw) { const int kb0 = k0 + 16 * hi;
#pragma unroll
                for (int r = 0; r < 16; ++r) { if (kb0 + r >= qrow) p0[r] = -INFINITY; if (kb0 + 32 + r >= qrow) p1[r] = -INFINITY; } }
            f32x16 m0, m1; float T0 = 0.f, T1 = 0.f;
#pragma unroll
            for (int r = 0; r < 16; ++r) {
                { const float z = p0[r], e = __builtin_amdgcn_exp2f(-__builtin_fabsf(z)), tt = __builtin_amdgcn_logf(1.0f + e); m0[r] = -(__builtin_fmaxf(z, 0.f) + tt); T0 += m0[r]; }
                { const float z = p1[r], e = __builtin_amdgcn_exp2f(-__builtin_fabsf(z)), tt = __builtin_amdgcn_logf(1.0f + e); m1[r] = -(__builtin_fmaxf(z, 0.f) + tt); T1 += m1[r]; }
            }
            const float PT0 = __shfl_xor(T0, 32), PT1 = __shfl_xor(T1, 32);
            float s1 = C + (hi ? 0.f : PT1), s0 = C + T1 + PT1 + (hi ? 0.f : PT0);
            C += (T0 + T1) + (PT0 + PT1);
#pragma unroll
            for (int r = 15; r >= 0; --r) { p1[r] = __builtin_amdgcn_exp2f(p1[r] + m1[r] + s1); s1 += m1[r]; }
#pragma unroll
            for (int r = 15; r >= 0; --r) { p0[r] = __builtin_amdgcn_exp2f(p0[r] + m0[r] + s0); s0 += m0[r]; }
#pragma unroll
            for (int s = 0; s < 2; ++s) {
                { const bf16x8 pf = pack8(p0, s); const bf16x8 v0 = *(const LAS bf16x8*)(vb + va_off + (8 * s) * 2), v1 = *(const LAS bf16x8*)(vb + va_off + 32 * KP * 2 + (8 * s) * 2);
                  o0 = MFMA32(v0, pf, o0); o1 = MFMA32(v1, pf, o1); }
                { const bf16x8 pf = pack8(p1, s); const bf16x8 v0 = *(const LAS bf16x8*)(vb + va_off + (32 + 8 * s) * 2), v1 = *(const LAS bf16x8*)(vb + va_off + 32 * KP * 2 + (32 + 8 * s) * 2);
                  o0 = MFMA32(v0, pf, o0); o1 = MFMA32(v1, pf, o1); }
            }
            wdone = __all(C <= -150.0f);
        }
        if (wdone && lane == 0) __hip_atomic_fetch_add((LAS unsigned*)(lds + 4 * TILEB) + (it & 3), 1u, __ATOMIC_RELAXED, __HIP_MEMORY_SCOPE_WORKGROUP);
        if (tid == 0) cnt[(it + 2) & 3] = 0u;
        if (t > 0) { *(LAS u32x4*)(lds + (cur ^ 1) * TILEB + lds_st) = kreg; *(LAS u32x4*)(lds + 2 * TILEB + (cur ^ 1) * TILEB + lds_st) = vreg; }
        __syncthreads(); cur ^= 1;
        if (cnt[it & 3] == 8u) break;
    }
    bf16* Op = MIX + (tokbase + qrow) * DM + h * 64 + 4 * hi;
#pragma unroll
    for (int g4 = 0; g4 < 4; ++g4) {
        u32x2 w0, w1; w0.x = pk_bf16(o0[4 * g4], o0[4 * g4 + 1]); w0.y = pk_bf16(o0[4 * g4 + 2], o0[4 * g4 + 3]); w1.x = pk_bf16(o1[4 * g4], o1[4 * g4 + 1]); w1.y = pk_bf16(o1[4 * g4 + 2], o1[4 * g4 + 3]);
        *(u32x2*)(Op + 8 * g4) = w0; *(u32x2*)(Op + 32 + 8 * g4) = w1; }
    __syncthreads();
}

__device__ __forceinline__ void swa_unit(LAS unsigned char* lds, const bf16* PA, bf16* MIX, const float* sinks, int b, int kvh, int qblk) {
    int tid_l = threadIdx.x; asm volatile("" : "+v"(tid_l));
    const int tid = tid_l, lane = tid & 63, wid = __builtin_amdgcn_readfirstlane(tid >> 6), r32 = lane & 31, hi = lane >> 5;
    const int g = wid & 3, rh = wid >> 2, hq = kvh * 4 + g, q0 = qblk * 64, qw = q0 + rh * 32, qrow = qw + r32; const size_t tokbase = (size_t)b * SEQ;
    const int lrow = tid >> 3, lch = tid & 7; const int lds_st = (lrow * KP + lch * 8) * 2;
#pragma unroll
    for (int j = 0; j < 3; ++j) { int key = q0 - 128 + 64 * j + lrow; key = key < 0 ? 0 : key;
        const bf16* rp = PA + (tokbase + key) * NPA + kvh * 64 + lch * 8;
        const u32x4 kreg = *(const u32x4*)(rp + 1536), vreg = *(const u32x4*)(rp + 1664);
        *(LAS u32x4*)(lds + j * TILEB + lds_st) = kreg;
        LAS unsigned short* vt = (LAS unsigned short*)(lds + (3 + j) * TILEB) + (lch * 8) * KP + lrow;
        vt[0 * KP] = (unsigned short)(vreg.x & 0xffffu); vt[1 * KP] = (unsigned short)(vreg.x >> 16); vt[2 * KP] = (unsigned short)(vreg.y & 0xffffu); vt[3 * KP] = (unsigned short)(vreg.y >> 16);
        vt[4 * KP] = (unsigned short)(vreg.z & 0xffffu); vt[5 * KP] = (unsigned short)(vreg.z >> 16); vt[6 * KP] = (unsigned short)(vreg.w & 0xffffu); vt[7 * KP] = (unsigned short)(vreg.w >> 16); }
    bf16x8 qr[4];
    { const bf16* Qp = PA + (tokbase + qrow) * NPA + 1024 + hq * 64 + hi * 8;
#pragma unroll
      for (int ds = 0; ds < 4; ++ds) qr[ds] = *(const bf16x8*)(Qp + 16 * ds); }
    const float sink2 = sinks[hq] * 1.4426950408889634f;
    __syncthreads();
    const int kp = 16 * ((r32 >> 2) & 1) + (r32 & 3) + 4 * (r32 >> 3);
    const int ka_off = (kp * KP + 8 * hi) * 2, va_off = (r32 * KP + 16 * hi) * 2;
    f32x16 p[3][2];
#pragma unroll
    for (int j = 0; j < 3; ++j) {
#pragma unroll
        for (int r = 0; r < 16; ++r) { p[j][0][r] = 0.f; p[j][1][r] = 0.f; }
#pragma unroll
        for (int ds = 0; ds < 4; ++ds) { const bf16x8 a0 = *(const LAS bf16x8*)(lds + j * TILEB + ka_off + ds * 32), a1 = *(const LAS bf16x8*)(lds + j * TILEB + ka_off + 32 * KP * 2 + ds * 32);
            p[j][0] = MFMA32(a0, qr[ds], p[j][0]); p[j][1] = MFMA32(a1, qr[ds], p[j][1]); }
    }
    float mx = sink2;
#pragma unroll
    for (int j = 0; j < 3; ++j)
#pragma unroll
        for (int g2 = 0; g2 < 2; ++g2)
#pragma unroll
            for (int r = 0; r < 16; ++r) { const int key = q0 - 128 + 64 * j + 32 * g2 + 16 * hi + r; const int df = qrow - key;
                const bool valid = (key >= 0) && (df >= 0) && (df < 128);
                const float v = valid ? p[j][g2][r] : -INFINITY; p[j][g2][r] = v; mx = __builtin_fmaxf(mx, v); }
    mx = __builtin_fmaxf(mx, __shfl_xor(mx, 32));
    float sum = 0.f;
#pragma unroll
    for (int j = 0; j < 3; ++j)
#pragma unroll
        for (int g2 = 0; g2 < 2; ++g2)
#pragma unroll
            for (int r = 0; r < 16; ++r) { const float e = __builtin_amdgcn_exp2f(p[j][g2][r] - mx); p[j][g2][r] = e; sum += e; }
    sum += __shfl_xor(sum, 32); sum += __builtin_amdgcn_exp2f(sink2 - mx);
    f32x16 o0, o1;
#pragma unroll
    for (int r = 0; r < 16; ++r) { o0[r] = 0.f; o1[r] = 0.f; }
#pragma unroll
    for (int j = 0; j < 3; ++j)
#pragma unroll
        for (int g2 = 0; g2 < 2; ++g2)
#pragma unroll
            for (int s = 0; s < 2; ++s) { const bf16x8 pf = pack8(p[j][g2], s); LAS unsigned char* vb = lds + (3 + j) * TILEB + va_off + (32 * g2 + 8 * s) * 2;
                const bf16x8 v0 = *(const LAS bf16x8*)(vb), v1 = *(const LAS bf16x8*)(vb + 32 * KP * 2);
                o0 = MFMA32(v0, pf, o0); o1 = MFMA32(v1, pf, o1); }
    const float inv = 1.0f / sum;
    bf16* Op = MIX + (tokbase + qrow) * DM + 512 + hq * 64 + 4 * hi;
#pragma unroll
    for (int g4 = 0; g4 < 4; ++g4) {
        u32x2 w0, w1; w0.x = pk_bf16(o0[4 * g4] * inv, o0[4 * g4 + 1] * inv); w0.y = pk_bf16(o0[4 * g4 + 2] * inv, o0[4 * g4 + 3] * inv);
        w1.x = pk_bf16(o1[4 * g4] * inv, o1[4 * g4 + 1] * inv); w1.y = pk_bf16(o1[4 * g4 + 2] * inv, o1[4 * g4 + 3] * inv);
        *(u32x2*)(Op + 8 * g4) = w0; *(u32x2*)(Op + 32 + 8 * g4) = w1; }
    __syncthreads();
}

__global__ void __launch_bounds__(NWAVES * 64, 2) fwd_megakernel(Args a) {
    extern __shared__ __attribute__((aligned(16))) unsigned char lds_raw[];
    LAS unsigned char* lds = (LAS unsigned char*)lds_raw;
    cg::grid_group grid = cg::this_grid();
    const int tid = threadIdx.x, lane = tid & 63, wave = __builtin_amdgcn_readfirstlane(tid >> 6);
    const int G = gridDim.x, bx = blockIdx.x, vcu = (G % 8 == 0) ? (bx % 8) * (G / 8) + bx / 8 : bx;
    const int gw = vcu * NWAVES + wave, NGW = G * NWAVES;
    unsigned char* ws = a.ws;
    float* ssq = (float*)(ws + WS_SSQ); const float* rope = (const float*)(ws + WS_ROPE);
    bf16* XB = (bf16*)(ws + WS_XB); bf16* MIX = (bf16*)(ws + WS_MIX); bf16* H = (bf16*)(ws + WS_H); bf16* PA = (bf16*)(ws + WS_PA); bf16* VT = (bf16*)(ws + WS_VT);
    const int lo = a.ph_lo, hi = a.ph_hi;
    int ph = 0;
    volatile LAS unsigned* bst = (volatile LAS unsigned*)(lds + 131072 + 512);
    if (tid < 2) bst[tid] = 0u;
    __syncthreads();
    unsigned* barw = (unsigned*)(ws + WS_BAR);
    XcdBarrier bar; bar.bar = barw; bar.x = 0; bar.st = bst;
#define PHASE_BEGIN if (ph >= lo && ph < hi) {
#define PHASE_END   if (ph + 1 < hi) { if (ph == 0) { grid.sync(); bar = xcd_barrier_post(barw, bst); } else xcd_barrier(bar); } } ++ph;

    PHASE_BEGIN
#ifndef NO_PRO
    prologue(a, lds, vcu, G, wave, lane);
#endif
    PHASE_END

    for (int l = 0; l < DEPTH; ++l) {
        const unsigned char* wl = ws + WS_W + (size_t)l * W_LAYER;
        const bf16* Win_t = (const bf16*)(wl + W_IN); const bf16* Wout_t = (const bf16*)(wl + W_OUT); const bf16* Wup_t = (const bf16*)(wl + W_UP); const bf16* Wdown_t = (const bf16*)(wl + W_DOWN);
        const float* ssqA = ssq + (size_t)(2 * l) * MTOK; float* ssqB = ssq + (size_t)(2 * l + 1) * MTOK; float* ssqAn = ssq + (size_t)(2 * l + 2) * MTOK;
        PHASE_BEGIN
#ifndef NO_G1
            { pg8::Gemm g{XB, Win_t, MTOK, NPA, DM}; pg8::StaticOrder S; S.init(MTOK, NPA, G, bx);
              pg8::EpiProj E{PA, ssqA, rope}; pg8::gemm_phase<pg8::EpiProj, pg8::StaticOrder, true, true>(lds, g, S, E); }
#endif
#ifndef NO_G2
            { pg8::Gemm g{Win_t + (size_t)NPA * DM, XB, 512, MTOK, DM}; pg8::StaticOrder S; S.init(512, MTOK, G, bx);
              pg8::EpiVT E{VT, ssqA, MTOK}; pg8::gemm_phase<pg8::EpiVT, pg8::StaticOrder, true, true>(lds, g, S, E); }
#endif
        PHASE_END
        PHASE_BEGIN
            for (int i = vcu; i < 1024; i += G) { const int v = i & 255, rd = i >> 8, bh = v >> 2, s = v & 3; const int qb = rd == 0 ? s : rd == 1 ? 7 - s : rd == 2 ? 8 + s : 15 - s;
#ifndef NO_SB
                sb_unit(lds, PA, VT, MIX, bh >> 3, bh & 7, qb);
#endif
            }
#ifndef NO_SWA
            for (int i = vcu; i < 1024; i += G) swa_unit(lds, PA, MIX, (const float*)(ws + WS_MISC) + l * 8, i >> 7, (i >> 6) & 1, i & 63);
#endif
        PHASE_END
        PHASE_BEGIN
            for (int m = gw; m < MTOK; m += NGW) { u32x4* rp = (u32x4*)(MIX + (size_t)m * DM) + lane;
#pragma unroll
                for (int hgrp = 0; hgrp < 2; ++hgrp) { const u32x4 w = rp[64 * hgrp];
                    const float f0 = bf_lo(w.x), f1 = bf_hi(w.x), f2 = bf_lo(w.y), f3 = bf_hi(w.y), f4 = bf_lo(w.z), f5 = bf_hi(w.z), f6 = bf_lo(w.w), f7 = bf_hi(w.w);
                    const float ss = wave_sum((f0 * f0 + f1 * f1) + (f2 * f2 + f3 * f3) + (f4 * f4 + f5 * f5) + (f6 * f6 + f7 * f7));
                    const float rs = __builtin_amdgcn_rsqf(ss * (1.0f / 512.0f) + RMS_EPS);
                    u32x4 o; o.x = pk_bf16(f0 * rs, f1 * rs); o.y = pk_bf16(f2 * rs, f3 * rs); o.z = pk_bf16(f4 * rs, f5 * rs); o.w = pk_bf16(f6 * rs, f7 * rs);
                    rp[64 * hgrp] = o; } }
        PHASE_END
        PHASE_BEGIN
#ifndef NO_G3
            { pg8::Gemm g{MIX, Wout_t, MTOK, DM, DM}; pg8::StaticOrder S; S.init(MTOK, DM, G, bx);
              pg8::EpiRes E{l == 0 ? a.x : a.out, a.out, XB, ssqB}; pg8::gemm_phase<pg8::EpiRes, pg8::StaticOrder, true, true>(lds, g, S, E); }
#endif
        PHASE_END
        PHASE_BEGIN
#ifndef NO_G4
            { pg8::Gemm g{XB, Wup_t, MTOK, DFF, DM}; pg8::StaticOrder S; S.init(MTOK, DFF, G, bx);
              pg8::EpiUp E{H, ssqB, DFF}; pg8::gemm_phase<pg8::EpiUp, pg8::StaticOrder, true, true>(lds, g, S, E); }
#endif
        PHASE_END
        PHASE_BEGIN
#ifndef NO_G5
            { pg8::Gemm g{H, Wdown_t, MTOK, DM, DFF}; pg8::StaticOrder S; S.init(MTOK, DM, G, bx);
              pg8::EpiRes E{a.out, a.out, XB, ssqAn}; pg8::gemm_phase<pg8::EpiRes, pg8::StaticOrder, true, true>(lds, g, S, E); }
#endif
        PHASE_END
    }
    PHASE_BEGIN
        const float* ssqF = ssq + (size_t)(2 * DEPTH) * MTOK;
        for (int m = gw; m < MTOK; m += NGW) { f32x4* xr = (f32x4*)(a.out + (size_t)m * DM) + lane; const float rs = __builtin_amdgcn_rsqf(ssqF[m] * (1.0f / 1024.0f) + RMS_EPS);
#pragma unroll
            for (int j = 0; j < 4; ++j) { const f32x4 gq = *((const f32x4*)(ws + WS_MISC + 4096) + lane + 64 * j); xr[64 * j] = xr[64 * j] * rs * gq; } }
    PHASE_END
#undef PHASE_BEGIN
#undef PHASE_END
}

#ifndef MK_SPLIT
#define MK_SPLIT 0
#endif
constexpr int N_PHASES = 1 + 6 * DEPTH + 1;
extern "C" void kernel_launch(void* const* d_in, const int* in_sizes, int n_in, void* d_out, int out_size, void* d_ws, size_t ws_size, hipStream_t stream) {
    static int grid = 0;
    if (grid == 0) {
        if (n_in != 12 || in_sizes[0] != MTOK * DM || out_size != MTOK * DM || ws_size < WS_END) { fprintf(stderr, "kernel_launch: unexpected shapes (n_in %d, in0 %d, out %d, ws %zu); nothing launched\n", n_in, n_in > 0 ? in_sizes[0] : -1, out_size, ws_size); grid = -1; return; }
        int dev = 0, cus = 0, per_cu = 0;
        if (hipGetDevice(&dev) != hipSuccess || hipDeviceGetAttribute(&cus, hipDeviceAttributeMultiprocessorCount, dev) != hipSuccess) { grid = -1; return; }
        if (hipFuncSetAttribute((const void*)fwd_megakernel, hipFuncAttributeMaxDynamicSharedMemorySize, LDS_BYTES) != hipSuccess) { fprintf(stderr, "kernel_launch: hipFuncSetAttribute failed\n"); grid = -1; return; }
        if (hipOccupancyMaxActiveBlocksPerMultiprocessor(&per_cu, (const void*)fwd_megakernel, NWAVES * 64, LDS_BYTES) != hipSuccess || per_cu < 1) { fprintf(stderr, "kernel_launch: occupancy query says %d blocks per CU\n", per_cu); per_cu = 1; }
        (void)hipGetLastError();
        grid = cus;
    }
    if (grid < 0) return;
    Args a{};
    a.x = (const float*)d_in[0]; a.pos = (const int*)d_in[1]; a.attn_norm = (const float*)d_in[2]; a.w_in = (const float*)d_in[3]; a.sb_norm = (const float*)d_in[4]; a.swa_norm = (const float*)d_in[5];
    a.sinks = (const float*)d_in[6]; a.w_out = (const float*)d_in[7]; a.mlp_norm = (const float*)d_in[8]; a.w_up = (const float*)d_in[9]; a.w_down = (const float*)d_in[10]; a.final_norm = (const float*)d_in[11];
    a.out = (float*)d_out; a.ws = (unsigned char*)d_ws;
#if MK_SPLIT
    for (int p = 0; p < N_PHASES; ++p) { a.ph_lo = p; a.ph_hi = p + 1; hipLaunchKernelGGL(fwd_megakernel, dim3(grid), dim3(NWAVES * 64), LDS_BYTES, stream, a); }
#else
    a.ph_lo = 0; a.ph_hi = N_PHASES;
    void* args[] = {&a};
    hipError_t e = hipLaunchCooperativeKernel((const void*)fwd_megakernel, dim3(grid), dim3(NWAVES * 64), args, LDS_BYTES, stream);
    if (e != hipSuccess) fprintf(stderr, "kernel_launch: cooperative launch failed: %s (grid %d)\n", hipGetErrorString(e), grid);
#endif
}
```
